# Optimizing an MI355X kernel written in HIP

```python
import jax, jax.numpy as jnp
from jax import lax
import numpy as np

D_MODEL = 1024
BATCH = 8
SEQ = 2048
DEPTH = 1
DEC_BATCH = 128
DEC_SEQ = 4
PAST_LEN = 16384
PAGE_SIZE = 128

D_RWKV = D_MODEL // 2
HEAD_DIM = 64
N_HEADS = D_RWKV // HEAD_DIM
D_CONV = D_MODEL - D_RWKV
CONV_WIDTH = 31
DECAY_RANK = 64
ICLR_RANK = 64
GATE_RANK = 128
D_FF = ((8 * D_MODEL // 3 + 127) // 128) * 128
N_SHIFT = 3 * D_RWKV + DECAY_RANK + ICLR_RANK + GATE_RANK
D_IN = N_SHIFT + 2 * D_CONV
N_SUB = 3
RMS_EPS = 1e-6
LN_EPS = 1e-5
GN_EPS = 64e-5

kernel_name = "hymba_rwkv7_conformer_macaron_step"


def rms_norm(x, g):
    xf = x.astype(jnp.float32)
    y = xf * lax.rsqrt(jnp.mean(xf * xf, -1, keepdims=True) + RMS_EPS)
    return (y * g.astype(jnp.float32)).astype(x.dtype)


def layer_norm(x, g, b, eps):
    xf = x.astype(jnp.float32)
    mu = jnp.mean(xf, -1, keepdims=True)
    var = jnp.mean(jnp.square(xf - mu), -1, keepdims=True)
    y = (xf - mu) * lax.rsqrt(var + eps) * g.astype(jnp.float32) + b.astype(jnp.float32)
    return y.astype(x.dtype)


def swiglu(h, w_up, w_down):
    gate, up = jnp.split(h @ w_up, 2, axis=-1)
    return (jax.nn.silu(gate) * up) @ w_down


def wkv7_scan(S0, r, decay, k, v, a_vec, b_vec):
    def step(S, inp):
        r_t, w_t, k_t, v_t, a_t, b_t = inp
        sa = jnp.einsum('bhvk,bhk->bhv', S, a_t)
        S = (S * w_t[:, :, None, :] + sa[..., None] * b_t[:, :, None, :]
             + v_t[..., None] * k_t[:, :, None, :])
        return S, jnp.einsum('bhvk,bhk->bhv', S, r_t)
    seq = tuple(jnp.moveaxis(z, 1, 0) for z in (r, decay, k, v, a_vec, b_vec))
    S, y = lax.scan(step, S0, seq)
    return S, jnp.moveaxis(y, 0, 1)


def token_mix(h, shift_prev, conv_prev, wkv_prev, p):
    b, t, _ = h.shape
    f32 = jnp.float32
    proj = h @ p['w_in']
    p_sh, p_cv = proj[..., :N_SHIFT], proj[..., N_SHIFT:]
    prev = jnp.concatenate([shift_prev.astype(proj.dtype), p_sh[:, :-1]], axis=1)
    xs = p_sh + (prev - p_sh) * p['mu_shift']
    new_shift = p_sh[:, -1:]
    o1, o2, o3 = D_RWKV, 2 * D_RWKV, 3 * D_RWKV
    o4, o5 = o3 + DECAY_RANK, o3 + DECAY_RANK + ICLR_RANK
    r, k, v = xs[..., :o1], xs[..., o1:o2], xs[..., o2:o3]
    dw, da, dg = xs[..., o3:o4], xs[..., o4:o5], xs[..., o5:]
    logw = -jax.nn.softplus(-(p['w0'] + jnp.tanh(dw) @ p['w_decay_up']).astype(f32)) - 0.5
    decay = jnp.exp(-jnp.exp(logw))
    iclr = jax.nn.sigmoid((p['a0'] + da @ p['w_iclr_up']).astype(f32))
    gate = jax.nn.sigmoid(dg) @ p['w_gate_up']
    heads = lambda z: z.astype(f32).reshape(b, t, N_HEADS, HEAD_DIM)
    kf = k.astype(f32)
    kk = heads(kf * p['k_k'].astype(f32))
    kk = kk / jnp.maximum(jnp.sqrt(jnp.sum(kk * kk, -1, keepdims=True)), 1e-12)
    kmod = kf * (1.0 + (iclr - 1.0) * p['k_a'].astype(f32))
    rh, kh, vh, wh, ah = heads(r), heads(kmod), heads(v), heads(decay), heads(iclr)
    S, y = wkv7_scan(wkv_prev.astype(f32), rh, wh, kh, vh, -kk, kk * ah)
    mu = jnp.mean(y, -1, keepdims=True)
    var = jnp.mean(jnp.square(y - mu), -1, keepdims=True)
    y = ((y - mu) * lax.rsqrt(var + GN_EPS)).reshape(b, t, D_RWKV)
    y = y * p['ln_x_g'].astype(f32) + p['ln_x_b'].astype(f32)
    bonus = jnp.sum(rh * kh * p['r_k'].astype(f32), -1, keepdims=True) * vh
    y_rwkv = (y + bonus.reshape(b, t, D_RWKV)).astype(h.dtype) * gate
    u_a, u_g = jnp.split(p_cv, 2, axis=-1)
    u = u_a * jax.nn.sigmoid(u_g)
    full = jnp.concatenate([conv_prev.astype(u.dtype), u], axis=1)
    new_conv = full[:, -(CONV_WIDTH - 1):]
    z = lax.conv_general_dilated(full, p['conv_w'].astype(full.dtype)[:, None, :],
                                 window_strides=(1,), padding='VALID',
                                 dimension_numbers=('NWC', 'WIO', 'NWC'),
                                 feature_group_count=D_CONV) + p['conv_b']
    z = jax.nn.silu(layer_norm(z, p['conv_ln_g'], p['conv_ln_b'], LN_EPS))
    mixed = jnp.concatenate([y_rwkv, z], axis=-1) @ p['w_out']
    return mixed, new_shift, new_conv, S.astype(wkv_prev.dtype)


def decoder_layer(x, c, shift_prev, conv_prev, wkv_prev, p):
    bsz = c.shape[0]
    ada = (jax.nn.silu(c) @ p['w_ada'] + p['b_ada']).reshape(bsz, N_SUB, 3, 1, D_MODEL)

    def modulated(x, i):
        return rms_norm(x, p['g_pre'][i]) * (1 + ada[:, i, 1]) + ada[:, i, 0]

    def residual(x, i, out, res_w):
        return x + res_w * ada[:, i, 2] * rms_norm(out, p['g_post'][i])

    x = residual(x, 0, swiglu(modulated(x, 0), p['w_ffn1_up'], p['w_ffn1_down']), 0.5)
    mixed, new_shift, new_conv, new_wkv = token_mix(modulated(x, 1), shift_prev, conv_prev, wkv_prev, p)
    x = residual(x, 1, mixed, 1.0)
    x = residual(x, 2, swiglu(modulated(x, 2), p['w_ffn2_up'], p['w_ffn2_down']), 0.5)
    return x, new_wkv, new_shift, new_conv


def setup_inputs(seed: int = 0) -> dict:
    key = jax.random.key(seed)
    ks = jax.random.split(key, 32)
    nrm = lambda i, shape, s: jax.random.normal(ks[i], shape, jnp.float32) * s
    return {
        'x_prompt': nrm(0, (BATCH, SEQ, D_MODEL), 1.0),
        'x_sample': nrm(1, (DEC_BATCH, DEC_SEQ, D_MODEL), 1.0),
        'c_prompt': nrm(2, (BATCH, D_MODEL), 1.0),
        'c_sample': nrm(3, (DEC_BATCH, D_MODEL), 1.0),
        'state_wkv': nrm(4, (DEC_BATCH, N_HEADS, HEAD_DIM, HEAD_DIM), 0.1),
        'state_shift': nrm(5, (DEC_BATCH, 1, N_SHIFT), 1.0),
        'state_conv': nrm(6, (DEC_BATCH, CONV_WIDTH - 1, D_CONV), 0.5),
        'w_ada': nrm(7, (D_MODEL, N_SUB * 3 * D_MODEL), D_MODEL ** -0.5),
        'b_ada': nrm(8, (N_SUB * 3 * D_MODEL,), 0.1),
        'g_pre': 1.0 + nrm(9, (N_SUB, D_MODEL), 0.05),
        'g_post': 1.0 + nrm(10, (N_SUB, D_MODEL), 0.05),
        'w_ffn1_up': nrm(11, (D_MODEL, 2 * D_FF), D_MODEL ** -0.5),
        'w_ffn1_down': nrm(12, (D_FF, D_MODEL), D_FF ** -0.5),
        'w_in': nrm(13, (D_MODEL, D_IN), D_MODEL ** -0.5),
        'mu_shift': jax.random.uniform(ks[14], (N_SHIFT,), jnp.float32),
        'w0': nrm(15, (D_RWKV,), 0.5) - 0.5,
        'w_decay_up': nrm(16, (DECAY_RANK, D_RWKV), 0.1 * DECAY_RANK ** -0.5),
        'a0': nrm(17, (D_RWKV,), 0.3),
        'w_iclr_up': nrm(18, (ICLR_RANK, D_RWKV), 0.5 * ICLR_RANK ** -0.5),
        'w_gate_up': nrm(19, (GATE_RANK, D_RWKV), GATE_RANK ** -0.5),
        'k_k': 0.85 + nrm(20, (D_RWKV,), 0.05),
        'k_a': 1.0 + nrm(21, (D_RWKV,), 0.05),
        'r_k': nrm(22, (N_HEADS, HEAD_DIM), 0.1),
        'ln_x_g': 1.0 + nrm(23, (D_RWKV,), 0.05),
        'ln_x_b': nrm(24, (D_RWKV,), 0.02),
        'conv_w': nrm(25, (CONV_WIDTH, D_CONV), CONV_WIDTH ** -0.5),
        'conv_b': nrm(26, (D_CONV,), 0.02),
        'conv_ln_g': 1.0 + nrm(27, (D_CONV,), 0.05),
        'conv_ln_b': nrm(28, (D_CONV,), 0.02),
        'w_out': nrm(29, (D_MODEL, D_MODEL), D_MODEL ** -0.5),
        'w_ffn2_up': nrm(30, (D_MODEL, 2 * D_FF), D_MODEL ** -0.5),
        'w_ffn2_down': nrm(31, (D_FF, D_MODEL), D_FF ** -0.5),
    }


def reference(x_prompt, x_sample, c_prompt, c_sample, state_wkv, state_shift, state_conv,
              w_ada, b_ada, g_pre, g_post, w_ffn1_up, w_ffn1_down, w_in, mu_shift, w0,
              w_decay_up, a0, w_iclr_up, w_gate_up, k_k, k_a, r_k, ln_x_g, ln_x_b,
              conv_w, conv_b, conv_ln_g, conv_ln_b, w_out, w_ffn2_up, w_ffn2_down):
    p = dict(w_ada=w_ada, b_ada=b_ada, g_pre=g_pre, g_post=g_post,
             w_ffn1_up=w_ffn1_up, w_ffn1_down=w_ffn1_down, w_in=w_in, mu_shift=mu_shift,
             w0=w0, w_decay_up=w_decay_up, a0=a0, w_iclr_up=w_iclr_up, w_gate_up=w_gate_up,
             k_k=k_k, k_a=k_a, r_k=r_k, ln_x_g=ln_x_g, ln_x_b=ln_x_b, conv_w=conv_w,
             conv_b=conv_b, conv_ln_g=conv_ln_g, conv_ln_b=conv_ln_b, w_out=w_out,
             w_ffn2_up=w_ffn2_up, w_ffn2_down=w_ffn2_down)
    y_p = x_prompt
    wkv_p = jnp.zeros((BATCH, N_HEADS, HEAD_DIM, HEAD_DIM), state_wkv.dtype)
    shift_p = jnp.zeros((BATCH, 1, N_SHIFT), x_prompt.dtype)
    conv_p = jnp.zeros((BATCH, CONV_WIDTH - 1, D_CONV), x_prompt.dtype)
    y_s, wkv_s, shift_s, conv_s = x_sample, state_wkv, state_shift, state_conv
    for _ in range(DEPTH):
        y_p, wkv_p, shift_p, conv_p = decoder_layer(y_p, c_prompt, shift_p, conv_p, wkv_p, p)
        y_s, wkv_s, shift_s, conv_s = decoder_layer(y_s, c_sample, shift_s, conv_s, wkv_s, p)
    return (y_p, y_s, wkv_p, shift_p, conv_p, wkv_s, shift_s, conv_s)
```

```cpp
#include <hip/hip_runtime.h>
#include <hip/hip_cooperative_groups.h>
#include <cstdio>
#include <cstdint>
namespace cg = cooperative_groups;

namespace pg8 {
#define PG8_LAS __attribute__((address_space(3)))
typedef unsigned short bf16_t;
typedef short bf16x8 __attribute__((ext_vector_type(8)));
typedef float f32x4 __attribute__((ext_vector_type(4)));
typedef unsigned u32x4 __attribute__((ext_vector_type(4)));
constexpr int BM = 256, BK = 64, HALF = 128, HTB = HALF * BK * 2  , STAGE_BYTES = 8 * HTB, NXCD = 8, WGM = 8;

__host__ __device__ __forceinline__ int lds_byte(int r, int c) { const int st = (r >> 4) * 2 + (c >> 5), rr = r & 15, cc = c & 31, ob = rr * 64 + cc * 2; return st * 1024 + (ob ^ (((ob >> 9) & 1) << 5)); }
__host__ __device__ __forceinline__ void stage_rc(int b, int& R, int& C) { const int st = b / 1024, sb = b % 1024, swz = sb ^ (((sb >> 9) & 1) << 5); R = (st >> 1) * 16 + swz / 64; C = (st & 1) * 32 + (swz % 64) / 2; }
__host__ __device__ __forceinline__ int perm32(int rho) { const int n = rho >> 4, i = rho & 15; return 8 * (i >> 2) + 4 * n + (i & 3); }

struct Unit { int pm, pn; };
struct Gemm { const bf16_t* A; const bf16_t* Bt; int M, N, K; };

struct StaticOrder {
    int nM, nN, nwg, G, c;
    __host__ __device__ void init(int M, int N, int G_, int c_) { nM = M / BM; nN = N / BM; nwg = nM * nN; G = G_; c = c_; }
    __host__ __device__ bool next(int i, Unit& u) const {
        const long L = (long)i * G + c; if (L >= nwg) return false;
        int wgid = (int)L; { const int q = nwg / NXCD, r = nwg % NXCD, xcd = wgid % NXCD, off = wgid / NXCD; wgid = (xcd < r ? xcd * (q + 1) : r * (q + 1) + (xcd - r) * q) + off; }
        const int nig = WGM * nN, gid = wgid / nig, fm = gid * WGM, gsz = (nM - fm) < WGM ? (nM - fm) : WGM;
        u.pm = fm + ((wgid % nig) % gsz); u.pn = (wgid % nig) / gsz; return true;
    }
    __device__ __forceinline__ void a_ready(const Unit&) const {}
    __device__ __forceinline__ void done(const Unit&) const {}
};

__device__ __forceinline__ unsigned cvt_pk_bf16(float lo, float hi) { unsigned r; asm volatile("v_cvt_pk_bf16_f32 %0, %1, %2" : "=v"(r) : "v"(lo), "v"(hi)); return r; }
__device__ __forceinline__ float fast_sigmoid(float x) { return __builtin_amdgcn_rcpf(1.0f + __builtin_amdgcn_exp2f(-1.4426950408889634f * x)); }

struct EpiF32B {
    static constexpr bool PERM = false, AFTER_DRAIN = false;
    float* C; int ldc; const float* bias;
    __device__ __forceinline__ void operator()(const f32x4 (&acc)[2][2][4][2], const Unit& u, int wr, int wc, int fr, int fq) const {
        const int row0 = u.pm * BM + wr * 64 + fr, col0 = u.pn * BM + wc * 32 + 4 * fq;
        f32x4 bv[2][2];
#pragma unroll
        for (int bj = 0; bj < 2; ++bj)
#pragma unroll
            for (int n = 0; n < 2; ++n) bv[bj][n] = *(const f32x4*)(bias + col0 + bj * HALF + n * 16);
#pragma unroll
        for (int ai = 0; ai < 2; ++ai)
#pragma unroll
            for (int m = 0; m < 4; ++m) { float* rowp = C + (size_t)(row0 + ai * HALF + m * 16) * ldc + col0;
#pragma unroll
                for (int bj = 0; bj < 2; ++bj)
#pragma unroll
                    for (int n = 0; n < 2; ++n) *(f32x4*)(rowp + bj * HALF + n * 16) = acc[ai][bj][m][n] + bv[bj][n]; }
    }
};
struct EpiBf16P {
    static constexpr bool PERM = true, AFTER_DRAIN = false;
    bf16_t* O; int ldc;
    __device__ __forceinline__ void operator()(const f32x4 (&acc)[2][2][4][2], const Unit& u, int wr, int wc, int fr, int fq) const {
        const int row0 = u.pm * BM + wr * 64 + fr, col0 = u.pn * BM + wc * 32 + 8 * fq;
#pragma unroll
        for (int ai = 0; ai < 2; ++ai)
#pragma unroll
            for (int m = 0; m < 4; ++m) { bf16_t* rowp = O + (size_t)(row0 + ai * HALF + m * 16) * ldc + col0;
#pragma unroll
                for (int bj = 0; bj < 2; ++bj) { const f32x4 v0 = acc[ai][bj][m][0], v1 = acc[ai][bj][m][1];
                    u32x4 w; w.x = cvt_pk_bf16(v0[0], v0[1]); w.y = cvt_pk_bf16(v0[2], v0[3]); w.z = cvt_pk_bf16(v1[0], v1[1]); w.w = cvt_pk_bf16(v1[2], v1[3]);
                    *(u32x4*)(rowp + bj * HALF) = w; } }
    }
};
struct EpiSwiglu {
    static constexpr bool PERM = true, AFTER_DRAIN = false;
    bf16_t* O; int ldc;
    __device__ __forceinline__ void operator()(const f32x4 (&acc)[2][2][4][2], const Unit& u, int wr, int wc, int fr, int fq) const {
        const int row0 = u.pm * BM + wr * 64 + fr, col0 = u.pn * HALF + wc * 32 + 8 * fq;
#pragma unroll
        for (int ai = 0; ai < 2; ++ai)
#pragma unroll
            for (int m = 0; m < 4; ++m) { bf16_t* rowp = O + (size_t)(row0 + ai * HALF + m * 16) * ldc + col0;
                float h[8];
#pragma unroll
                for (int n = 0; n < 2; ++n)
#pragma unroll
                    for (int i = 0; i < 4; ++i) { const float g = acc[ai][0][m][n][i], up = acc[ai][1][m][n][i]; h[n * 4 + i] = g * fast_sigmoid(g) * up; }
                u32x4 w; w.x = cvt_pk_bf16(h[0], h[1]); w.y = cvt_pk_bf16(h[2], h[3]); w.z = cvt_pk_bf16(h[4], h[5]); w.w = cvt_pk_bf16(h[6], h[7]);
                *(u32x4*)rowp = w; }
    }
};

template <class Epi, class Sched, bool ALIGN_EPI = false, bool SP2 = false>
__device__ __forceinline__ void gemm_phase(PG8_LAS unsigned char* lds, const Gemm g, const Sched& S, const Epi& E) {
    int tid_ = threadIdx.x; asm volatile("" : "+v"(tid_)); const int tid = tid_, wid = __builtin_amdgcn_readfirstlane(tid >> 6), lane = tid & 63, wr = wid >> 2, wc = wid & 3, fr = lane & 15, fq = lane >> 4;
    const int K = g.K, nt = K / BK;
    unsigned voffA[2], voffB[2];
#pragma unroll
    for (int i = 0; i < 2; ++i) { int R, C; stage_rc(tid * 16 + i * 8192, R, C); const int Rb = Epi::PERM ? ((R & ~31) + perm32(R & 31)) : R;
        voffA[i] = (unsigned)(R * K + C) * 2u; voffB[i] = (unsigned)(Rb * K + C) * 2u; }
    const size_t kstep = (size_t)(BK * 2);
    const size_t hstep = (size_t)HALF * K * 2;
    const size_t tstep = 2 * hstep;
    const unsigned ldsw = (unsigned)wid * 1024u;
    const int aoff = lds_byte(wr * 64 + fr, fq * 8), boff = lds_byte(wc * 32 + fr, fq * 8);
#define PG8_SA(b, h) (((b) * 2 + (h)) * HTB)
#define PG8_SB(b, h) ((4 + (b) * 2 + (h)) * HTB)
#define PG8_STAGE(bufoff, gbase, voff) do { _Pragma("unroll") for (int _i = 0; _i < 2; ++_i) \
        __builtin_amdgcn_global_load_lds((const unsigned*)((const char*)(gbase) + (voff)[_i]), (PG8_LAS unsigned*)(lds + (bufoff) + ldsw + _i * 8192), 16, 0, 0); } while (0)
#define PG8_LDA(dst, b, h) do { _Pragma("unroll") for (int m = 0; m < 4; ++m) _Pragma("unroll") for (int k = 0; k < 2; ++k) dst[m][k] = *(const PG8_LAS bf16x8*)(lds + PG8_SA(b, h) + aoff + m * 2048 + k * 1024); } while (0)
#define PG8_LDB(dst, b, h) do { _Pragma("unroll") for (int n = 0; n < 2; ++n) _Pragma("unroll") for (int k = 0; k < 2; ++k) dst[n][k] = *(const PG8_LAS bf16x8*)(lds + PG8_SB(b, h) + boff + n * 2048 + k * 1024); } while (0)
#define PG8_MMA(ai, bj, At, Bt) do { __builtin_amdgcn_s_setprio(1); _Pragma("unroll") for (int m = 0; m < 4; ++m) _Pragma("unroll") for (int n = 0; n < 2; ++n) _Pragma("unroll") for (int k = 0; k < 2; ++k) \
        acc[ai][bj][m][n] = __builtin_amdgcn_mfma_f32_16x16x32_bf16(Bt[n][k], At[m][k], acc[ai][bj][m][n], 0, 0, 0); __builtin_amdgcn_s_setprio(0); } while (0)
#define PG8_WAIT_V(n) asm volatile("s_waitcnt vmcnt(" #n ")" ::: "memory")
#define PG8_WAIT_L(n) asm volatile("s_waitcnt lgkmcnt(" #n ")" ::: "memory")
#define PG8_BAR __builtin_amdgcn_s_barrier()
#define PG8_SCHED __builtin_amdgcn_sched_barrier(0)
    Unit cur, nxt; int ui = 0;
    if (!S.next(0, cur)) return;
    f32x4 acc[2][2][4][2];
#pragma unroll
    for (int a = 0; a < 2; ++a)
#pragma unroll
        for (int b = 0; b < 2; ++b)
#pragma unroll
            for (int m = 0; m < 4; ++m)
#pragma unroll
                for (int n = 0; n < 2; ++n) acc[a][b][m][n] = (f32x4){0.f, 0.f, 0.f, 0.f};
    bf16x8 At[4][2], B0[2][2], B1[2][2];
    const char* cA = (const char*)g.A + (size_t)cur.pm * tstep; const char* cB = (const char*)g.Bt + (size_t)cur.pn * tstep;
    S.a_ready(cur);
    if constexpr (SP2) {
        PG8_STAGE(PG8_SB(0, 0), cB, voffB); PG8_STAGE(PG8_SB(0, 1), cB + hstep, voffB); PG8_STAGE(PG8_SA(0, 0), cA, voffA); PG8_STAGE(PG8_SA(0, 1), cA + hstep, voffA);
        if (wr == 1) PG8_BAR;
        PG8_WAIT_V(2); PG8_BAR;
        PG8_STAGE(PG8_SB(1, 0), cB + kstep, voffB); PG8_STAGE(PG8_SA(1, 0), cA + kstep, voffA); PG8_STAGE(PG8_SB(1, 1), cB + hstep + kstep, voffB);
        PG8_WAIT_V(6); PG8_BAR;
    } else {
        PG8_STAGE(PG8_SB(0, 0), cB, voffB); PG8_STAGE(PG8_SA(0, 0), cA, voffA); PG8_STAGE(PG8_SB(0, 1), cB + hstep, voffB); PG8_STAGE(PG8_SA(0, 1), cA + hstep, voffA);
        if (wr == 1) PG8_BAR;
        PG8_WAIT_V(4); PG8_BAR;
        PG8_STAGE(PG8_SB(1, 0), cB + kstep, voffB); PG8_STAGE(PG8_SA(1, 0), cA + kstep, voffA); PG8_STAGE(PG8_SB(1, 1), cB + hstep + kstep, voffB);
        PG8_WAIT_V(6); PG8_BAR;
    }
    for (;;) {
        const bool has_next = S.next(ui + 1, nxt);
        const char* nA = has_next ? (const char*)g.A + (size_t)nxt.pm * tstep : cA; const char* nB = has_next ? (const char*)g.Bt + (size_t)nxt.pn * tstep : cB;
        for (int t = 0; t < nt; t += 2) {
            const bool last = (t == nt - 2);
            const char* a1 = cA + (size_t)(t + 1) * kstep;
            const char* a2 = last ? nA : cA + (size_t)(t + 2) * kstep; const char* b2 = last ? nB : cB + (size_t)(t + 2) * kstep;
            const char* a3 = a2 + kstep; const char* b3 = b2 + kstep;
            if (last && has_next) S.a_ready(nxt);
            if constexpr (SP2) {
            PG8_LDB(B0, 0, 0); PG8_LDB(B1, 0, 1); PG8_SCHED; PG8_LDA(At, 0, 0); PG8_STAGE(PG8_SA(1, 1), a1 + hstep, voffA);
            PG8_WAIT_V(8); PG8_WAIT_L(0); PG8_BAR; PG8_MMA(0, 0, At, B0); PG8_MMA(0, 1, At, B1); PG8_BAR; PG8_SCHED;
            PG8_LDA(At, 0, 1); PG8_STAGE(PG8_SB(0, 0), b2, voffB); PG8_STAGE(PG8_SB(0, 1), b2 + hstep, voffB); PG8_STAGE(PG8_SA(0, 0), a2, voffA);
            PG8_WAIT_V(8); PG8_WAIT_L(0); PG8_BAR; PG8_MMA(1, 0, At, B0); PG8_MMA(1, 1, At, B1); PG8_BAR; PG8_SCHED;
            PG8_LDB(B0, 1, 0); PG8_LDB(B1, 1, 1); PG8_SCHED; PG8_LDA(At, 1, 0); PG8_STAGE(PG8_SA(0, 1), a2 + hstep, voffA);
            PG8_WAIT_V(8); PG8_WAIT_L(0); PG8_BAR; PG8_MMA(0, 0, At, B0); PG8_MMA(0, 1, At, B1); PG8_BAR; PG8_SCHED;
            PG8_LDA(At, 1, 1); PG8_STAGE(PG8_SB(1, 0), b3, voffB); PG8_STAGE(PG8_SB(1, 1), b3 + hstep, voffB); PG8_STAGE(PG8_SA(1, 0), a3, voffA);
            PG8_WAIT_V(8); PG8_WAIT_L(0); PG8_BAR; PG8_MMA(1, 0, At, B0); PG8_MMA(1, 1, At, B1); PG8_BAR; PG8_SCHED;
            } else {
            PG8_LDB(B0, 0, 0); PG8_SCHED; PG8_LDA(At, 0, 0); PG8_STAGE(PG8_SA(1, 1), a1 + hstep, voffA);
            PG8_WAIT_L(8); PG8_BAR; PG8_WAIT_L(0); PG8_MMA(0, 0, At, B0); PG8_BAR; PG8_SCHED;
            PG8_LDB(B1, 0, 1); PG8_STAGE(PG8_SB(0, 0), b2, voffB);
            PG8_BAR; PG8_WAIT_L(0); PG8_MMA(0, 1, At, B1); PG8_BAR;
            PG8_LDA(At, 0, 1); PG8_STAGE(PG8_SA(0, 0), a2, voffA);
            PG8_BAR; PG8_WAIT_L(0); PG8_MMA(1, 0, At, B0); PG8_BAR; PG8_SCHED;
            PG8_STAGE(PG8_SB(0, 1), b2 + hstep, voffB);
            PG8_WAIT_V(6); PG8_BAR; PG8_MMA(1, 1, At, B1); PG8_BAR;
            PG8_LDB(B0, 1, 0); PG8_SCHED; PG8_LDA(At, 1, 0); PG8_STAGE(PG8_SA(0, 1), a2 + hstep, voffA);
            PG8_WAIT_L(8); PG8_BAR; PG8_WAIT_L(0); PG8_MMA(0, 0, At, B0); PG8_BAR; PG8_SCHED;
            PG8_LDB(B1, 1, 1); PG8_STAGE(PG8_SB(1, 0), b3, voffB);
            PG8_BAR; PG8_WAIT_L(0); PG8_MMA(0, 1, At, B1); PG8_BAR;
            PG8_LDA(At, 1, 1); PG8_STAGE(PG8_SA(1, 0), a3, voffA);
            PG8_BAR; PG8_WAIT_L(0); PG8_MMA(1, 0, At, B0); PG8_BAR; PG8_SCHED;
            PG8_STAGE(PG8_SB(1, 1), b3 + hstep, voffB);
            PG8_WAIT_V(6); PG8_BAR; PG8_MMA(1, 1, At, B1); PG8_BAR;
            }
        }
        if constexpr (ALIGN_EPI) { if (wr == 0) PG8_BAR; }
        if constexpr (!Epi::AFTER_DRAIN) { E(acc, cur, wr, wc, fr, fq); S.done(cur); }
        if (!has_next) break;
#pragma unroll
        for (int a = 0; a < 2; ++a)
#pragma unroll
            for (int b = 0; b < 2; ++b)
#pragma unroll
                for (int m = 0; m < 4; ++m)
#pragma unroll
                    for (int n = 0; n < 2; ++n) acc[a][b][m][n] = (f32x4){0.f, 0.f, 0.f, 0.f};
        cur = nxt; cA = nA; cB = nB; ++ui;
        if constexpr (ALIGN_EPI) { if (wr == 1) PG8_BAR; }
    }
    PG8_WAIT_V(0);
    if constexpr (!ALIGN_EPI) { if (wr == 0) PG8_BAR; }
    PG8_BAR;
    if constexpr (Epi::AFTER_DRAIN) { E.fused(acc, cur, wr, wc, fr, fq, lds, wid, lane); S.done(cur); }
#undef PG8_SA
#undef PG8_SB
#undef PG8_STAGE
#undef PG8_LDA
#undef PG8_LDB
#undef PG8_MMA
#undef PG8_WAIT_V
#undef PG8_WAIT_L
#undef PG8_BAR
#undef PG8_SCHED
}
}

#define LAS __attribute__((address_space(3)))
typedef unsigned short bf16_t;
typedef float f32x4 __attribute__((ext_vector_type(4)));
typedef unsigned u32x4 __attribute__((ext_vector_type(4)));
typedef unsigned u32x2 __attribute__((ext_vector_type(2)));
constexpr int DM = 1024, NPT = 16384, NST = 512, MT = NPT + NST, TSEQ = 2048;
constexpr int DFF = 2816, NUP = 5632, DIN = 2816, NSH = 1792, DRW = 512, DCV = 512, CWID = 31, NLR = 1536, KLR = 256, NADA = 9216;
constexpr float RMS_EPS = 1e-6f, LN_EPS = 1e-5f, GN_EPS = 64e-5f, LOG2E = 1.4426950408889634f;
constexpr size_t O_Y = 0, O_WKVP = 17301504, O_SHP = 17563648, O_CVP = 17577984, O_WKVS = 17700864, O_SHS = 21895168, O_CVS = 22124544, O_END = 24090624;
constexpr size_t MiB = 1u << 20;
constexpr size_t WS_ADA = 0;
constexpr size_t WS_SC = 9437184;
constexpr size_t WS_WADA = 10 * MiB;
constexpr size_t WS_WUP1 = 28 * MiB;
constexpr size_t WS_WDN1 = 39 * MiB;
constexpr size_t WS_WIN = WS_WDN1 + 5767168;
constexpr size_t WS_WLR = 50 * MiB;
constexpr size_t WS_WOUT = 51 * MiB;
constexpr size_t WS_WUP2 = 53 * MiB;
constexpr size_t WS_WDN2 = 64 * MiB;
constexpr size_t WS_L = 70 * MiB;
constexpr size_t WS_H = 79 * MiB;
constexpr size_t WS_D = 112 * MiB;
constexpr size_t WS_ACT = 162 * MiB;
constexpr size_t WS_END = WS_ACT + (size_t)MT * DFF * 2;
static_assert(WS_END <= 256 * MiB, "ws map");
constexpr int LDS_BYTES = 147456;

struct KArgs { const float* in[32]; float* out; unsigned char* ws; };
typedef const __attribute__((address_space(4))) KArgs* KP;

__device__ __forceinline__ float bf_lo(unsigned u) { return __builtin_bit_cast(float, u << 16); }
__device__ __forceinline__ float bf_hi(unsigned u) { return __builtin_bit_cast(float, u & 0xffff0000u); }
__device__ __forceinline__ float bf1(bf16_t b) { return __builtin_bit_cast(float, ((unsigned)b) << 16); }
__device__ __forceinline__ unsigned pk2(float lo, float hi) { return pg8::cvt_pk_bf16(lo, hi); }
__device__ __forceinline__ float sigm(float x) { return pg8::fast_sigmoid(x); }
__device__ __forceinline__ float tanh_fast(float x) { const float e = __builtin_amdgcn_exp2f(2.0f * LOG2E * x); return 1.0f - 2.0f * __builtin_amdgcn_rcpf(e + 1.0f); }
__device__ __forceinline__ float rsq(float x) { return 1.0f / sqrtf(x); }
__device__ __forceinline__ void ld8bf(const bf16_t* p, float (&o)[8]) { const u32x4 r = *(const u32x4*)p;
    o[0] = bf_lo(r.x); o[1] = bf_hi(r.x); o[2] = bf_lo(r.y); o[3] = bf_hi(r.y); o[4] = bf_lo(r.z); o[5] = bf_hi(r.z); o[6] = bf_lo(r.w); o[7] = bf_hi(r.w); }
__device__ __forceinline__ void ld8f(const float* p, float (&o)[8]) { const f32x4 a = *(const f32x4*)p, b = *(const f32x4*)(p + 4);
    o[0] = a.x; o[1] = a.y; o[2] = a.z; o[3] = a.w; o[4] = b.x; o[5] = b.y; o[6] = b.z; o[7] = b.w; }
__device__ __forceinline__ f32x4 ld4bf(const bf16_t* p) { const u32x2 r = *(const u32x2*)p; return (f32x4){bf_lo(r.x), bf_hi(r.x), bf_lo(r.y), bf_hi(r.y)}; }
__device__ __forceinline__ float wave_sum(float v) {
#pragma unroll
    for (int o = 1; o < 64; o <<= 1) v += __shfl_xor(v, o);
    return v;
}
template <int CTRL> __device__ __forceinline__ float dpp_mov(float x) { return __builtin_bit_cast(float, __builtin_amdgcn_update_dpp(0, __builtin_bit_cast(int, x), CTRL, 0xF, 0xF, true)); }
__device__ __forceinline__ float red8(float x) { x += dpp_mov<0xB1>(x); x += dpp_mov<0x4E>(x); x += dpp_mov<0x141>(x); return x; }
__device__ __forceinline__ float red16(float x) { x = red8(x); x += dpp_mov<0x140>(x); return x; }
__device__ __forceinline__ int batch_of_row(int m) { return m < NPT ? (m >> 11) : 8 + ((m - NPT) >> 2); }
#define LDS_WAIT() asm volatile("s_waitcnt lgkmcnt(0)" ::: "memory")

__device__ __forceinline__ void p0_transpose_item(const float* W, int K, int N, bf16_t* WT, int swi, LAS float* scr, int item, int lane) {
    const int nblk = N / 32, kb = item / nblk, nb = item % nblk, k0 = 64 * kb, n0 = 32 * nb;
    int s0 = n0;
    if (swi) { const int pn = n0 >> 8, bj = (n0 >> 7) & 1, j0 = n0 & 127; s0 = bj * DFF + 128 * pn + j0; }
#pragma unroll 8
    for (int i = 0; i < 32; ++i) { const int kk = 2 * i + (lane >> 5); scr[kk * 33 + (lane & 31)] = W[(size_t)(k0 + kk) * N + s0 + (lane & 31)]; }
    LDS_WAIT(); asm volatile("" ::: "memory");
    const int c = lane & 7;
#pragma unroll
    for (int j = 0; j < 4; ++j) { const int n = (lane >> 3) + 8 * j; const LAS float* s = scr + (8 * c) * 33 + n;
        u32x4 o; o.x = pk2(s[0 * 33], s[1 * 33]); o.y = pk2(s[2 * 33], s[3 * 33]); o.z = pk2(s[4 * 33], s[5 * 33]); o.w = pk2(s[6 * 33], s[7 * 33]);
        *(u32x4*)(WT + (size_t)(n0 + n) * K + k0 + 8 * c) = o; }
    LDS_WAIT(); asm volatile("" ::: "memory");
}
__device__ __forceinline__ void p0_prologue(KP A, LAS unsigned char* lds, int tid, int wave, int lane) {
    LAS float* scr = (LAS float*)(lds + wave * 16384);
    const int gw = blockIdx.x * 8 + wave, NGW = gridDim.x * 8;
    unsigned char* ws = A->ws;
    constexpr int I_ADA = 16 * (NADA / 32), I_UP = 16 * (NUP / 32), I_DN = (DFF / 64) * (DM / 32), I_IN = 16 * (DIN / 32), I_OUT = 16 * (DM / 32);
    constexpr int NITEMS = I_ADA + 2 * I_UP + 2 * I_DN + I_IN + I_OUT;
    for (int it = gw; it < NITEMS; it += NGW) {
        int r = it;
        if (r < I_ADA) { p0_transpose_item(A->in[7], DM, NADA, (bf16_t*)(ws + WS_WADA), 0, scr, r, lane); continue; } r -= I_ADA;
        if (r < I_UP) { p0_transpose_item(A->in[11], DM, NUP, (bf16_t*)(ws + WS_WUP1), 1, scr, r, lane); continue; } r -= I_UP;
        if (r < I_UP) { p0_transpose_item(A->in[30], DM, NUP, (bf16_t*)(ws + WS_WUP2), 1, scr, r, lane); continue; } r -= I_UP;
        if (r < I_DN) { p0_transpose_item(A->in[12], DFF, DM, (bf16_t*)(ws + WS_WDN1), 0, scr, r, lane); continue; } r -= I_DN;
        if (r < I_DN) { p0_transpose_item(A->in[31], DFF, DM, (bf16_t*)(ws + WS_WDN2), 0, scr, r, lane); continue; } r -= I_DN;
        if (r < I_IN) { p0_transpose_item(A->in[13], DM, DIN, (bf16_t*)(ws + WS_WIN), 0, scr, r, lane); continue; } r -= I_IN;
        p0_transpose_item(A->in[29], DM, DM, (bf16_t*)(ws + WS_WOUT), 0, scr, r, lane);
    }
    const int gt = blockIdx.x * 512 + tid, NGT = gridDim.x * 512;
    bf16_t* wlr = (bf16_t*)(ws + WS_WLR);
    for (int i = gt; i < NLR * KLR; i += NGT) {
        const int n = i >> 8, k = i & 255; float v = 0.f;
        if (n < 512) { if (k < 64) v = A->in[16][k * 512 + n]; }
        else if (n < 1024) { if (k >= 64 && k < 128) v = A->in[18][(k - 64) * 512 + (n - 512)]; }
        else { if (k >= 128) v = A->in[19][(k - 128) * 512 + (n - 1024)]; }
        wlr[i] = (bf16_t)(pk2(v, 0.f) & 0xffffu);
    }
    bf16_t* sc = (bf16_t*)(ws + WS_SC);
    for (int i = gt; i < 256 * DM; i += NGT) {
        const int b = i >> 10, c = i & 1023; float v = 0.f;
        if (b < 8) v = A->in[2][b * DM + c]; else if (b < 136) v = A->in[3][(b - 8) * DM + c];
        v = v * sigm(v);
        sc[i] = (bf16_t)(pk2(v, 0.f) & 0xffffu);
    }
}

template <int MODE>
__device__ __forceinline__ void row_pass(KP A, int wave, int lane, int sub_prev, float res_w, int sub_next) {
    const int gw = blockIdx.x * 8 + wave, NGW = gridDim.x * 8;
    const float* ada = (const float*)(A->ws + WS_ADA);
    const bf16_t* D = (const bf16_t*)(A->ws + WS_D);
    bf16_t* H = (bf16_t*)(A->ws + WS_H);
    const float* gpre = A->in[9] + sub_next * DM; const float* gpost = A->in[10] + sub_prev * DM;
    for (int m = gw; m < MT; m += NGW) {
        const float* adab = ada + (size_t)batch_of_row(m) * NADA;
        float* xo = A->out + (size_t)m * DM;
        const float* xi = (MODE == 0 || sub_prev == 0) ? (m < NPT ? A->in[0] + (size_t)m * DM : A->in[1] + (size_t)(m - NPT) * DM) : xo;
        f32x4 v[4];
#pragma unroll
        for (int j = 0; j < 4; ++j) v[j] = *(const f32x4*)(xi + 4 * lane + 256 * j);
        if (MODE >= 1) {
            f32x4 d[4]; float ss = 0.f;
#pragma unroll
            for (int j = 0; j < 4; ++j) { d[j] = ld4bf(D + (size_t)m * DM + 4 * lane + 256 * j); ss += (d[j].x * d[j].x + d[j].y * d[j].y) + (d[j].z * d[j].z + d[j].w * d[j].w); }
            const float rs = rsq(wave_sum(ss) * (1.0f / DM) + RMS_EPS);
#pragma unroll
            for (int j = 0; j < 4; ++j) { const int col = 4 * lane + 256 * j;
                const f32x4 g = *(const f32x4*)(gpost + col), gt = *(const f32x4*)(adab + (sub_prev * 3 + 2) * DM + col);
                v[j] = v[j] + (res_w * gt) * ((d[j] * rs) * g);
                *(f32x4*)(xo + col) = v[j]; }
        }
        if (MODE <= 1) {
            float ss = 0.f;
#pragma unroll
            for (int j = 0; j < 4; ++j) ss += (v[j].x * v[j].x + v[j].y * v[j].y) + (v[j].z * v[j].z + v[j].w * v[j].w);
            const float rs = rsq(wave_sum(ss) * (1.0f / DM) + RMS_EPS);
#pragma unroll
            for (int j = 0; j < 4; ++j) { const int col = 4 * lane + 256 * j;
                const f32x4 g = *(const f32x4*)(gpre + col), sc = *(const f32x4*)(adab + (sub_next * 3 + 1) * DM + col), sh = *(const f32x4*)(adab + (sub_next * 3 + 0) * DM + col);
                const f32x4 h = ((v[j] * rs) * g) * (1.0f + sc) + sh;
                u32x2 w; w.x = pk2(h.x, h.y); w.y = pk2(h.z, h.w);
                *(u32x2*)(H + (size_t)m * DM + col) = w; }
        }
    }
}

__device__ __forceinline__ void p7_lowrank_inputs(KP A, int wave, int lane) {
    const int gw = blockIdx.x * 8 + wave, NGW = gridDim.x * 8;
    const bf16_t* PROJ = (const bf16_t*)(A->ws + WS_ACT);
    bf16_t* L = (bf16_t*)(A->ws + WS_L);
    const float* mu = A->in[14];
    for (int m = gw; m < MT; m += NGW) {
        bool first, last; const float* st = nullptr; float* sho;
        if (m < NPT) { const int t = m & 2047; first = (t == 0); last = (t == 2047); sho = A->out + O_SHP + (size_t)(m >> 11) * NSH; }
        else { const int ms = m - NPT, seq = ms >> 2, t = ms & 3; first = (t == 0); last = (t == 3); st = A->in[5] + (size_t)seq * NSH; sho = A->out + O_SHS + (size_t)seq * NSH; }
        const int col = 1536 + 4 * lane;
        const f32x4 p = ld4bf(PROJ + (size_t)m * DIN + col);
        f32x4 pv = (f32x4){0.f, 0.f, 0.f, 0.f};
        if (!first) pv = ld4bf(PROJ + (size_t)(m - 1) * DIN + col); else if (st) pv = *(const f32x4*)(st + col);
        const f32x4 mm = *(const f32x4*)(mu + col);
        const f32x4 xs = p + (pv - p) * mm;
        f32x4 o;
        if (lane < 16) o = (f32x4){tanh_fast(xs.x), tanh_fast(xs.y), tanh_fast(xs.z), tanh_fast(xs.w)};
        else if (lane < 32) o = xs;
        else o = (f32x4){sigm(xs.x), sigm(xs.y), sigm(xs.z), sigm(xs.w)};
        u32x2 w; w.x = pk2(o.x, o.y); w.y = pk2(o.z, o.w);
        *(u32x2*)(L + (size_t)m * KLR + 4 * lane) = w;
        if (last) { for (int cc = 4 * lane; cc < NSH; cc += 256) *(f32x4*)(sho + cc) = ld4bf(PROJ + (size_t)m * DIN + cc); }
    }
}
__device__ __forceinline__ void conv_ln_store(KP A, LAS float* Z, int m0, int wave, int lane) {
    bf16_t* YZ = (bf16_t*)(A->ws + WS_H);
    float g[8], bb[8]; ld8f(A->in[27] + 8 * lane, g); ld8f(A->in[28] + 8 * lane, bb);
#pragma unroll
    for (int q = 0; q < 4; ++q) { const int tt = 4 * wave + q;
        const f32x4 a = *(const LAS f32x4*)(Z + tt * 512 + 8 * lane), b = *(const LAS f32x4*)(Z + tt * 512 + 8 * lane + 4);
        float z[8] = {a.x, a.y, a.z, a.w, b.x, b.y, b.z, b.w};
        float s = 0.f;
#pragma unroll
        for (int e = 0; e < 8; ++e) s += z[e];
        const float mean = wave_sum(s) * (1.0f / 512.0f); float qv = 0.f;
#pragma unroll
        for (int e = 0; e < 8; ++e) { z[e] -= mean; qv += z[e] * z[e]; }
        const float rs = rsq(wave_sum(qv) * (1.0f / 512.0f) + LN_EPS);
        float o[8];
#pragma unroll
        for (int e = 0; e < 8; ++e) { const float y = z[e] * rs * g[e] + bb[e]; o[e] = y * sigm(y); }
        u32x4 w; w.x = pk2(o[0], o[1]); w.y = pk2(o[2], o[3]); w.z = pk2(o[4], o[5]); w.w = pk2(o[6], o[7]);
        *(u32x4*)(YZ + (size_t)(m0 + tt) * DM + 512 + 8 * lane) = w; }
}
__device__ __forceinline__ void p7_conv(KP A, LAS unsigned char* lds, int tid, int wave, int lane) {
    const bf16_t* PROJ = (const bf16_t*)(A->ws + WS_ACT);
    LAS float* Z = (LAS float*)lds;
    const int c = tid;
    float w[CWID];
#pragma unroll
    for (int j = 0; j < CWID; ++j) w[j] = A->in[25][j * DCV + c];
    const float cb = A->in[26][c];
    for (int tile = blockIdx.x; tile < 512 + 16; tile += gridDim.x) {
        if (tile < 512) {
            const int b = tile >> 6, t0 = (tile & 63) * 32;
            const bf16_t* P = PROJ + (size_t)(b * TSEQ) * DIN + NSH + c;
            float u[62];
#pragma unroll
            for (int i = 0; i < 62; ++i) { const int t = t0 - 30 + i;
                if (t >= 0) { const float ua = bf1(P[(size_t)t * DIN]), ug = bf1(P[(size_t)t * DIN + DCV]); u[i] = ua * sigm(ug); } else u[i] = 0.f; }
#pragma unroll
            for (int t = 0; t < 32; ++t) { float acc = cb;
#pragma unroll
                for (int j = 0; j < CWID; ++j) acc += w[j] * u[t + j];
                Z[t * 512 + c] = acc; }
            if (t0 == TSEQ - 32) {
#pragma unroll
                for (int i = 0; i < 30; ++i) A->out[O_CVP + (size_t)(b * 30 + i) * DCV + c] = u[32 + i]; }
            __syncthreads();
            conv_ln_store(A, Z, b * TSEQ + t0, wave, lane);
            __syncthreads();
        } else {
            const int s0 = (tile - 512) * 8;
            for (int si = 0; si < 8; ++si) { const int seq = s0 + si;
                float f[34];
#pragma unroll
                for (int i = 0; i < 30; ++i) f[i] = A->in[6][(size_t)(seq * 30 + i) * DCV + c];
                const bf16_t* P = PROJ + (size_t)(NPT + seq * 4) * DIN + NSH + c;
#pragma unroll
                for (int t = 0; t < 4; ++t) { const float ua = bf1(P[(size_t)t * DIN]), ug = bf1(P[(size_t)t * DIN + DCV]); f[30 + t] = ua * sigm(ug); }
#pragma unroll
                for (int t = 0; t < 4; ++t) { float acc = cb;
#pragma unroll
                    for (int j = 0; j < CWID; ++j) acc += w[j] * f[t + j];
                    Z[(si * 4 + t) * 512 + c] = acc; }
#pragma unroll
                for (int i = 0; i < 30; ++i) A->out[O_CVS + (size_t)(seq * 30 + i) * DCV + c] = f[i + 4];
            }
            __syncthreads();
            conv_ln_store(A, Z, NPT + s0 * 4, wave, lane);
            __syncthreads();
        }
    }
}

constexpr int SC_R = 0, SC_W = 16384, SC_K = 32768, SC_A = 49152, SC_B = 65536, SC_V = 81920, SC_Y = 86016;
struct Slot { int m, seq, h, q; bool first, sample; };
__device__ __forceinline__ Slot slot_prompt(int item, int chunk, int s) { Slot x; x.seq = item >> 5; x.h = (item >> 2) & 7; x.q = item & 3; const int t = chunk * 64 + s; x.m = x.seq * TSEQ + t; x.first = (t == 0); x.sample = false; return x; }
__device__ __forceinline__ Slot slot_sample(int group, int s) { Slot x; const int i = group * 16 + (s >> 2), t = s & 3; x.seq = i >> 5; x.h = (i >> 2) & 7; x.q = i & 3; x.m = NPT + x.seq * 4 + t; x.first = (t == 0); x.sample = true; return x; }

__device__ __forceinline__ void lerp8(const bf16_t* PROJ, const float* st, const float* mu, const Slot& x, int col, float (&o)[8]) {
    float p[8], pv[8], mm[8];
    ld8bf(PROJ + (size_t)x.m * DIN + col, p);
    if (!x.first) ld8bf(PROJ + (size_t)(x.m - 1) * DIN + col, pv);
    else if (x.sample) ld8f(st + (size_t)x.seq * NSH + col, pv);
    else {
#pragma unroll
        for (int e = 0; e < 8; ++e) pv[e] = 0.f; }
    ld8f(mu + col, mm);
#pragma unroll
    for (int e = 0; e < 8; ++e) o[e] = p[e] + (pv[e] - p[e]) * mm[e];
}
__device__ __forceinline__ float rwkv_prep8(KP A, const Slot& x, int cg, float (&r)[8], float (&w)[8], float (&km)[8], float (&v)[8], float (&a)[8], float (&b)[8]) {
    const bf16_t* PROJ = (const bf16_t*)(A->ws + WS_ACT); const bf16_t* LR = (const bf16_t*)(A->ws + WS_D);
    const int gc = x.h * 64 + 8 * cg;
    float k[8];
    lerp8(PROJ, A->in[5], A->in[14], x, gc, r); lerp8(PROJ, A->in[5], A->in[14], x, 512 + gc, k); lerp8(PROJ, A->in[5], A->in[14], x, 1024 + gc, v);
    float dp[8], ip[8], w0[8], a0[8], kk_[8], ka[8], rk[8];
    ld8bf(LR + (size_t)x.m * NLR + gc, dp); ld8bf(LR + (size_t)x.m * NLR + 512 + gc, ip);
    ld8f(A->in[15] + gc, w0); ld8f(A->in[17] + gc, a0); ld8f(A->in[20] + gc, kk_); ld8f(A->in[21] + gc, ka); ld8f(A->in[22] + gc, rk);
    float ss = 0.f, bon = 0.f, ic[8], kv[8];
#pragma unroll
    for (int e = 0; e < 8; ++e) {
        const float sg = sigm(w0[e] + dp[e]);
        w[e] = __builtin_amdgcn_exp2f(-0.6065306597126334f * LOG2E * sg);
        ic[e] = sigm(a0[e] + ip[e]);
        kv[e] = k[e] * kk_[e]; ss += kv[e] * kv[e];
        km[e] = k[e] * (1.0f + (ic[e] - 1.0f) * ka[e]);
        bon += r[e] * km[e] * rk[e];
    }
    ss = red8(ss);
    const float inv = 1.0f / fmaxf(sqrtf(ss), 1e-12f);
#pragma unroll
    for (int e = 0; e < 8; ++e) { const float kn = kv[e] * inv; a[e] = -kn; b[e] = kn * ic[e]; }
    return bon;
}
__device__ __forceinline__ void scan_prep_store(KP A, LAS unsigned char* lds, const Slot& x, int s, int cg) {
    float r[8], w[8], km[8], v[8], a[8], b[8];
    (void)rwkv_prep8(A, x, cg, r, w, km, v, a, b);
    const int o = (s * 64 + 8 * cg) * 4;
    *(LAS f32x4*)(lds + SC_R + o) = (f32x4){r[0], r[1], r[2], r[3]}; *(LAS f32x4*)(lds + SC_R + o + 16) = (f32x4){r[4], r[5], r[6], r[7]};
    *(LAS f32x4*)(lds + SC_W + o) = (f32x4){w[0], w[1], w[2], w[3]}; *(LAS f32x4*)(lds + SC_W + o + 16) = (f32x4){w[4], w[5], w[6], w[7]};
    *(LAS f32x4*)(lds + SC_K + o) = (f32x4){km[0], km[1], km[2], km[3]}; *(LAS f32x4*)(lds + SC_K + o + 16) = (f32x4){km[4], km[5], km[6], km[7]};
    *(LAS f32x4*)(lds + SC_A + o) = (f32x4){a[0], a[1], a[2], a[3]}; *(LAS f32x4*)(lds + SC_A + o + 16) = (f32x4){a[4], a[5], a[6], a[7]};
    *(LAS f32x4*)(lds + SC_B + o) = (f32x4){b[0], b[1], b[2], b[3]}; *(LAS f32x4*)(lds + SC_B + o + 16) = (f32x4){b[4], b[5], b[6], b[7]};
    if ((cg >> 1) == x.q) { const int ov = (s * 16 + (cg & 1) * 8) * 4;
        *(LAS f32x4*)(lds + SC_V + ov) = (f32x4){v[0], v[1], v[2], v[3]}; *(LAS f32x4*)(lds + SC_V + ov + 16) = (f32x4){v[4], v[5], v[6], v[7]}; }
}
__device__ __forceinline__ void scan_step(LAS unsigned char* lds, int s, int row16, int kq, f32x4& S) {
    const int o = (s * 64 + 4 * kq) * 4;
    const f32x4 a = *(const LAS f32x4*)(lds + SC_A + o), w = *(const LAS f32x4*)(lds + SC_W + o), b = *(const LAS f32x4*)(lds + SC_B + o),
                k = *(const LAS f32x4*)(lds + SC_K + o), r = *(const LAS f32x4*)(lds + SC_R + o);
    const float vv = *(const LAS float*)(lds + SC_V + (s * 16 + row16) * 4);
    float sa = (S.x * a.x + S.y * a.y) + (S.z * a.z + S.w * a.w);
    const f32x4 pre = S * w + vv * k;
    sa = red16(sa);
    S = pre + sa * b;
    float y = (S.x * r.x + S.y * r.y) + (S.z * r.z + S.w * r.w);
    y = red16(y);
    if (kq == 0) *(LAS float*)(lds + SC_Y + (s * 16 + row16) * 4) = y;
}
__device__ __forceinline__ void scan_store_y(KP A, LAS unsigned char* lds, const Slot& x, int s, int pr) {
    bf16_t* YZ = (bf16_t*)(A->ws + WS_H);
    const float y0 = *(const LAS float*)(lds + SC_Y + (s * 16 + 2 * pr) * 4), y1 = *(const LAS float*)(lds + SC_Y + (s * 16 + 2 * pr + 1) * 4);
    *(unsigned*)(YZ + (size_t)x.m * DM + x.h * 64 + x.q * 16 + 2 * pr) = pk2(y0, y1);
}
__device__ __forceinline__ void p9_scan(KP A, LAS unsigned char* lds, int tid, int wave, int lane) {
    const int s_of = tid >> 3, cg = tid & 7;
    const int w4 = wave & 3, row16 = 4 * w4 + (lane >> 4), kq = lane & 15;
    for (int item = blockIdx.x; item < 256; item += gridDim.x) {
        f32x4 S = (f32x4){0.f, 0.f, 0.f, 0.f};
        for (int ch = 0; ch < 32; ++ch) {
            const Slot x = slot_prompt(item, ch, s_of);
            scan_prep_store(A, lds, x, s_of, cg);
            __syncthreads();
            if (wave < 4) { for (int s = 0; s < 64; ++s) scan_step(lds, s, row16, kq, S); }
            __syncthreads();
            scan_store_y(A, lds, x, s_of, cg);
        }
        if (wave < 4) { const int seq = item >> 5, h = (item >> 2) & 7, q = item & 3;
            *(f32x4*)(A->out + O_WKVP + ((size_t)(seq * 8 + h) * 64 + q * 16 + row16) * 64 + 4 * kq) = S; }
        __syncthreads();
    }
    for (int grp = blockIdx.x; grp < 256; grp += gridDim.x) {
        const Slot x = slot_sample(grp, s_of);
        scan_prep_store(A, lds, x, s_of, cg);
        const int half = wave >> 2;
        f32x4 S[8];
#pragma unroll
        for (int j = 0; j < 8; ++j) { const int i = grp * 16 + half * 8 + j, seq = i >> 5, h = (i >> 2) & 7, q = i & 3;
            S[j] = *(const f32x4*)(A->in[4] + ((size_t)(seq * 8 + h) * 64 + q * 16 + row16) * 64 + 4 * kq); }
        __syncthreads();
#pragma unroll
        for (int j = 0; j < 8; ++j) {
#pragma unroll
            for (int t = 0; t < 4; ++t) scan_step(lds, (half * 8 + j) * 4 + t, row16, kq, S[j]);
        }
#pragma unroll
        for (int j = 0; j < 8; ++j) { const int i = grp * 16 + half * 8 + j, seq = i >> 5, h = (i >> 2) & 7, q = i & 3;
            *(f32x4*)(A->out + O_WKVS + ((size_t)(seq * 8 + h) * 64 + q * 16 + row16) * 64 + 4 * kq) = S[j]; }
        __syncthreads();
        scan_store_y(A, lds, x, s_of, cg);
        __syncthreads();
    }
}

__device__ __forceinline__ void p10_finalize(KP A, int wave, int lane) {
    const int gw = blockIdx.x * 8 + wave, NGW = gridDim.x * 8;
    bf16_t* YZ = (bf16_t*)(A->ws + WS_H); const bf16_t* LR = (const bf16_t*)(A->ws + WS_D);
    float lg[8], lb[8]; ld8f(A->in[23] + 8 * lane, lg); ld8f(A->in[24] + 8 * lane, lb);
    for (int m = gw; m < MT; m += NGW) {
        Slot x; x.m = m; x.h = lane >> 3; x.q = 0;
        if (m < NPT) { x.seq = m >> 11; x.first = ((m & 2047) == 0); x.sample = false; } else { const int ms = m - NPT; x.seq = ms >> 2; x.first = ((ms & 3) == 0); x.sample = true; }
        float r[8], w[8], km[8], v[8], a[8], b[8];
        float bon = rwkv_prep8(A, x, lane & 7, r, w, km, v, a, b);
        bon = red8(bon);
        float y[8], gt[8]; ld8bf(YZ + (size_t)m * DM + 8 * lane, y); ld8bf(LR + (size_t)m * NLR + 1024 + 8 * lane, gt);
        float s = 0.f;
#pragma unroll
        for (int e = 0; e < 8; ++e) s += y[e];
        const float mean = red8(s) * (1.0f / 64.0f); float qv = 0.f;
#pragma unroll
        for (int e = 0; e < 8; ++e) { y[e] -= mean; qv += y[e] * y[e]; }
        const float rs = rsq(red8(qv) * (1.0f / 64.0f) + GN_EPS);
        float o[8];
#pragma unroll
        for (int e = 0; e < 8; ++e) o[e] = (y[e] * rs * lg[e] + lb[e] + bon * v[e]) * gt[e];
        u32x4 wv; wv.x = pk2(o[0], o[1]); wv.y = pk2(o[2], o[3]); wv.z = pk2(o[4], o[5]); wv.w = pk2(o[6], o[7]);
        *(u32x4*)(YZ + (size_t)m * DM + 8 * lane) = wv;
    }
}

#ifndef PHMASK
#define PHMASK 0xFFFF
#endif
constexpr int NPH = 16;
__global__ void __launch_bounds__(512) mk_fwd(KArgs A_unused) {
    extern __shared__ __attribute__((aligned(16))) unsigned char lds_raw[];
    LAS unsigned char* lds = (LAS unsigned char*)lds_raw;
    cg::grid_group grid = cg::this_grid();
    for (int ph = 0; ph < NPH; ++ph) {
        KP kp = (KP)__builtin_amdgcn_kernarg_segment_ptr(); asm volatile("" : "+s"(kp));
        int tid_ = threadIdx.x; asm volatile("" : "+v"(tid_));
        const int tid = tid_, lane = tid & 63, wave = __builtin_amdgcn_readfirstlane(tid >> 6);
        const KP A = kp;
        unsigned char* ws = A->ws;
        switch (ph) {
        case 0: if constexpr ((PHMASK & 0x1) != 0) p0_prologue(A, lds, tid, wave, lane); break;
        case 1: if constexpr ((PHMASK & 0x2) != 0) { pg8::Gemm g{(const bf16_t*)(ws + WS_SC), (const bf16_t*)(ws + WS_WADA), 256, NADA, DM}; pg8::StaticOrder S; S.init(256, NADA, gridDim.x, blockIdx.x);
                  pg8::EpiF32B E{(float*)(ws + WS_ADA), NADA, A->in[8]};
                  pg8::gemm_phase<pg8::EpiF32B, pg8::StaticOrder, true, true>(lds, g, S, E); } break;
        case 2: if constexpr ((PHMASK & 0x4) != 0) row_pass<0>(A, wave, lane, 0, 0.f, 0); break;
        case 3: case 13: if constexpr ((PHMASK & 0x2008) != 0) { pg8::Gemm g{(const bf16_t*)(ws + WS_H), (const bf16_t*)(ws + (ph == 3 ? WS_WUP1 : WS_WUP2)), MT, NUP, DM}; pg8::StaticOrder S; S.init(MT, NUP, gridDim.x, blockIdx.x);
                  pg8::EpiSwiglu E{(bf16_t*)(ws + WS_ACT), DFF};
                  pg8::gemm_phase<pg8::EpiSwiglu, pg8::StaticOrder, true, true>(lds, g, S, E); } break;
        case 4: case 6: case 8: case 11: case 14: if constexpr ((PHMASK & 0x4950) != 0) {
                  pg8::Gemm g; pg8::EpiBf16P E;
                  if (ph == 4)       { g = pg8::Gemm{(const bf16_t*)(ws + WS_ACT), (const bf16_t*)(ws + WS_WDN1), MT, DM, DFF}; E = pg8::EpiBf16P{(bf16_t*)(ws + WS_D), DM}; }
                  else if (ph == 14) { g = pg8::Gemm{(const bf16_t*)(ws + WS_ACT), (const bf16_t*)(ws + WS_WDN2), MT, DM, DFF}; E = pg8::EpiBf16P{(bf16_t*)(ws + WS_D), DM}; }
                  else if (ph == 6)  { g = pg8::Gemm{(const bf16_t*)(ws + WS_H), (const bf16_t*)(ws + WS_WIN), MT, DIN, DM}; E = pg8::EpiBf16P{(bf16_t*)(ws + WS_ACT), DIN}; }
                  else if (ph == 8)  { g = pg8::Gemm{(const bf16_t*)(ws + WS_L), (const bf16_t*)(ws + WS_WLR), MT, NLR, KLR}; E = pg8::EpiBf16P{(bf16_t*)(ws + WS_D), NLR}; }
                  else               { g = pg8::Gemm{(const bf16_t*)(ws + WS_H), (const bf16_t*)(ws + WS_WOUT), MT, DM, DM}; E = pg8::EpiBf16P{(bf16_t*)(ws + WS_D), DM}; }
                  pg8::StaticOrder S; S.init(g.M, g.N, gridDim.x, blockIdx.x);
                  pg8::gemm_phase<pg8::EpiBf16P, pg8::StaticOrder, true, true>(lds, g, S, E); } break;
        case 5: if constexpr ((PHMASK & 0x20) != 0) row_pass<1>(A, wave, lane, 0, 0.5f, 1); break;
        case 7: if constexpr ((PHMASK & 0x80) != 0) { p7_lowrank_inputs(A, wave, lane); p7_conv(A, lds, tid, wave, lane); } break;
        case 9: if constexpr ((PHMASK & 0x200) != 0) p9_scan(A, lds, tid, wave, lane); break;
        case 10: if constexpr ((PHMASK & 0x400) != 0) p10_finalize(A, wave, lane); break;
        case 12: if constexpr ((PHMASK & 0x1000) != 0) row_pass<1>(A, wave, lane, 1, 1.0f, 2); break;
        case 15: if constexpr ((PHMASK & 0x8000) != 0) row_pass<2>(A, wave, lane, 2, 0.5f, 0); break;
        }
        if (ph + 1 < NPH) grid.sync();
    }
}

extern "C" void kernel_launch(void* const* d_in, const int* in_sizes, int n_in, void* d_out, int out_size, void* d_ws, size_t ws_size, hipStream_t stream) {
    static int grid = 0;
    if (grid == 0) {
        if (n_in != 32 || out_size != (int)O_END || ws_size < WS_END) { fprintf(stderr, "kernel_launch: unexpected shapes: n_in %d out %d ws %zu (need %zu)\n", n_in, out_size, ws_size, (size_t)WS_END); grid = -1; return; }
        int dev = 0, cus = 0, per_cu = 0;
        hipGetDevice(&dev);
        hipDeviceGetAttribute(&cus, hipDeviceAttributeMultiprocessorCount, dev);
        if (hipFuncSetAttribute((const void*)mk_fwd, hipFuncAttributeMaxDynamicSharedMemorySize, LDS_BYTES) != hipSuccess) { fprintf(stderr, "kernel_launch: hipFuncSetAttribute failed\n"); grid = -1; return; }
        if (hipOccupancyMaxActiveBlocksPerMultiprocessor(&per_cu, (const void*)mk_fwd, 512, LDS_BYTES) != hipSuccess || per_cu < 1) { fprintf(stderr, "kernel_launch: occupancy query failed (%d)\n", per_cu); (void)hipGetLastError(); per_cu = 1; }
        grid = cus * per_cu;
        fprintf(stderr, "kernel_launch: cus %d per_cu %d grid %d\n", cus, per_cu, grid);
    }
    if (grid < 0) return;
    KArgs a{};
    for (int i = 0; i < 32; ++i) a.in[i] = (const float*)d_in[i];
    a.out = (float*)d_out; a.ws = (unsigned char*)d_ws;
    void* args[] = {&a};
    hipError_t e = hipLaunchCooperativeKernel((const void*)mk_fwd, dim3(grid), dim3(512), args, LDS_BYTES, stream);
    if (e != hipSuccess) fprintf(stderr, "kernel_launch: cooperative launch failed: %s (grid %d)\n", hipGetErrorString(e), grid);
}
```

```cpp
#include <hip/hip_runtime.h>
#include <hip/hip_cooperative_groups.h>
#include <cstdio>
#include <cstdint>
namespace cg = cooperative_groups;

namespace pg8 {
#define PG8_LAS __attribute__((address_space(3)))
typedef unsigned short bf16_t;
typedef short bf16x8 __attribute__((ext_vector_type(8)));
typedef float f32x4 __attribute__((ext_vector_type(4)));
typedef unsigned u32x4 __attribute__((ext_vector_type(4)));
constexpr int BM = 256, BK = 64, HALF = 128, HTB = HALF * BK * 2  , STAGE_BYTES = 8 * HTB, NXCD = 8, WGM = 8;

__host__ __device__ __forceinline__ int lds_byte(int r, int c) { const int st = (r >> 4) * 2 + (c >> 5), rr = r & 15, cc = c & 31, ob = rr * 64 + cc * 2; return st * 1024 + (ob ^ (((ob >> 9) & 1) << 5)); }
__host__ __device__ __forceinline__ void stage_rc(int b, int& R, int& C) { const int st = b / 1024, sb = b % 1024, swz = sb ^ (((sb >> 9) & 1) << 5); R = (st >> 1) * 16 + swz / 64; C = (st & 1) * 32 + (swz % 64) / 2; }
__host__ __device__ __forceinline__ int perm32(int rho) { const int n = rho >> 4, i = rho & 15; return 8 * (i >> 2) + 4 * n + (i & 3); }

struct Unit { int pm, pn; };
struct Gemm { const bf16_t* A; const bf16_t* Bt; int M, N, K; };

struct StaticOrder {
    int nM, nN, nwg, G, c;
    __host__ __device__ void init(int M, int N, int G_, int c_) { nM = M / BM; nN = N / BM; nwg = nM * nN; G = G_; c = c_; }
    __host__ __device__ bool next(int i, Unit& u) const {
        const long L = (long)i * G + c; if (L >= nwg) return false;
        int wgid = (int)L; { const int q = nwg / NXCD, r = nwg % NXCD, xcd = wgid % NXCD, off = wgid / NXCD; wgid = (xcd < r ? xcd * (q + 1) : r * (q + 1) + (xcd - r) * q) + off; }
        const int nig = WGM * nN, gid = wgid / nig, fm = gid * WGM, gsz = (nM - fm) < WGM ? (nM - fm) : WGM;
        u.pm = fm + ((wgid % nig) % gsz); u.pn = (wgid % nig) / gsz; return true;
    }
    __device__ __forceinline__ void a_ready(const Unit&) const {}
    __device__ __forceinline__ void done(const Unit&) const {}
};

__device__ __forceinline__ unsigned cvt_pk_bf16(float lo, float hi) { unsigned r; asm volatile("v_cvt_pk_bf16_f32 %0, %1, %2" : "=v"(r) : "v"(lo), "v"(hi)); return r; }
__device__ __forceinline__ float fast_sigmoid(float x) { return __builtin_amdgcn_rcpf(1.0f + __builtin_amdgcn_exp2f(-1.4426950408889634f * x)); }

struct EpiF32B {
    static constexpr bool PERM = false, AFTER_DRAIN = false;
    float* C; int ldc; const float* bias;
    __device__ __forceinline__ void operator()(const f32x4 (&acc)[2][2][4][2], const Unit& u, int wr, int wc, int fr, int fq) const {
        const int row0 = u.pm * BM + wr * 64 + fr, col0 = u.pn * BM + wc * 32 + 4 * fq;
        f32x4 bv[2][2];
#pragma unroll
        for (int bj = 0; bj < 2; ++bj)
#pragma unroll
            for (int n = 0; n < 2; ++n) bv[bj][n] = *(const f32x4*)(bias + col0 + bj * HALF + n * 16);
#pragma unroll
        for (int ai = 0; ai < 2; ++ai)
#pragma unroll
            for (int m = 0; m < 4; ++m) { float* rowp = C + (size_t)(row0 + ai * HALF + m * 16) * ldc + col0;
#pragma unroll
                for (int bj = 0; bj < 2; ++bj)
#pragma unroll
                    for (int n = 0; n < 2; ++n) *(f32x4*)(rowp + bj * HALF + n * 16) = acc[ai][bj][m][n] + bv[bj][n]; }
    }
};
struct EpiBf16P {
    static constexpr bool PERM = true, AFTER_DRAIN = false;
    bf16_t* O; int ldc;
    __device__ __forceinline__ void operator()(const f32x4 (&acc)[2][2][4][2], const Unit& u, int wr, int wc, int fr, int fq) const {
        const int row0 = u.pm * BM + wr * 64 + fr, col0 = u.pn * BM + wc * 32 + 8 * fq;
#pragma unroll
        for (int ai = 0; ai < 2; ++ai)
#pragma unroll
            for (int m = 0; m < 4; ++m) { bf16_t* rowp = O + (size_t)(row0 + ai * HALF + m * 16) * ldc + col0;
#pragma unroll
                for (int bj = 0; bj < 2; ++bj) { const f32x4 v0 = acc[ai][bj][m][0], v1 = acc[ai][bj][m][1];
                    u32x4 w; w.x = cvt_pk_bf16(v0[0], v0[1]); w.y = cvt_pk_bf16(v0[2], v0[3]); w.z = cvt_pk_bf16(v1[0], v1[1]); w.w = cvt_pk_bf16(v1[2], v1[3]);
                    *(u32x4*)(rowp + bj * HALF) = w; } }
    }
};
struct EpiSwiglu {
    static constexpr bool PERM = true, AFTER_DRAIN = false;
    bf16_t* O; int ldc;
    __device__ __forceinline__ void operator()(const f32x4 (&acc)[2][2][4][2], const Unit& u, int wr, int wc, int fr, int fq) const {
        const int row0 = u.pm * BM + wr * 64 + fr, col0 = u.pn * HALF + wc * 32 + 8 * fq;
#pragma unroll
        for (int ai = 0; ai < 2; ++ai)
#pragma unroll
            for (int m = 0; m < 4; ++m) { bf16_t* rowp = O + (size_t)(row0 + ai * HALF + m * 16) * ldc + col0;
                float h[8];
#pragma unroll
                for (int n = 0; n < 2; ++n)
#pragma unroll
                    for (int i = 0; i < 4; ++i) { const float g = acc[ai][0][m][n][i], up = acc[ai][1][m][n][i]; h[n * 4 + i] = g * fast_sigmoid(g) * up; }
                u32x4 w; w.x = cvt_pk_bf16(h[0], h[1]); w.y = cvt_pk_bf16(h[2], h[3]); w.z = cvt_pk_bf16(h[4], h[5]); w.w = cvt_pk_bf16(h[6], h[7]);
                *(u32x4*)rowp = w; }
    }
};

template <class Epi, class Sched, bool ALIGN_EPI = false, bool SP2 = false>
__device__ __forceinline__ void gemm_phase(PG8_LAS unsigned char* lds, const Gemm g, const Sched& S, const Epi& E) {
    int tid_ = threadIdx.x; asm volatile("" : "+v"(tid_)); const int tid = tid_, wid = __builtin_amdgcn_readfirstlane(tid >> 6), lane = tid & 63, wr = wid >> 2, wc = wid & 3, fr = lane & 15, fq = lane >> 4;
    const int K = g.K, nt = K / BK;
    unsigned voffA[2], voffB[2];
#pragma unroll
    for (int i = 0; i < 2; ++i) { int R, C; stage_rc(tid * 16 + i * 8192, R, C); const int Rb = Epi::PERM ? ((R & ~31) + perm32(R & 31)) : R;
        voffA[i] = (unsigned)(R * K + C) * 2u; voffB[i] = (unsigned)(Rb * K + C) * 2u; }
    const size_t kstep = (size_t)(BK * 2);
    const size_t hstep = (size_t)HALF * K * 2;
    const size_t tstep = 2 * hstep;
    const unsigned ldsw = (unsigned)wid * 1024u;
    const int aoff = lds_byte(wr * 64 + fr, fq * 8), boff = lds_byte(wc * 32 + fr, fq * 8);
#define PG8_SA(b, h) (((b) * 2 + (h)) * HTB)
#define PG8_SB(b, h) ((4 + (b) * 2 + (h)) * HTB)
#define PG8_STAGE(bufoff, gbase, voff) do { _Pragma("unroll") for (int _i = 0; _i < 2; ++_i) \
        __builtin_amdgcn_global_load_lds((const unsigned*)((const char*)(gbase) + (voff)[_i]), (PG8_LAS unsigned*)(lds + (bufoff) + ldsw + _i * 8192), 16, 0, 0); } while (0)
#define PG8_LDA(dst, b, h) do { _Pragma("unroll") for (int m = 0; m < 4; ++m) _Pragma("unroll") for (int k = 0; k < 2; ++k) dst[m][k] = *(const PG8_LAS bf16x8*)(lds + PG8_SA(b, h) + aoff + m * 2048 + k * 1024); } while (0)
#define PG8_LDB(dst, b, h) do { _Pragma("unroll") for (int n = 0; n < 2; ++n) _Pragma("unroll") for (int k = 0; k < 2; ++k) dst[n][k] = *(const PG8_LAS bf16x8*)(lds + PG8_SB(b, h) + boff + n * 2048 + k * 1024); } while (0)
#define PG8_MMA(ai, bj, At, Bt) do { __builtin_amdgcn_s_setprio(1); _Pragma("unroll") for (int m = 0; m < 4; ++m) _Pragma("unroll") for (int n = 0; n < 2; ++n) _Pragma("unroll") for (int k = 0; k < 2; ++k) \
        acc[ai][bj][m][n] = __builtin_amdgcn_mfma_f32_16x16x32_bf16(Bt[n][k], At[m][k], acc[ai][bj][m][n], 0, 0, 0); __builtin_amdgcn_s_setprio(0); } while (0)
#define PG8_WAIT_V(n) asm volatile("s_waitcnt vmcnt(" #n ")" ::: "memory")
#define PG8_WAIT_L(n) asm volatile("s_waitcnt lgkmcnt(" #n ")" ::: "memory")
#define PG8_BAR __builtin_amdgcn_s_barrier()
#define PG8_SCHED __builtin_amdgcn_sched_barrier(0)
    Unit cur, nxt; int ui = 0;
    if (!S.next(0, cur)) return;
    f32x4 acc[2][2][4][2];
#pragma unroll
    for (int a = 0; a < 2; ++a)
#pragma unroll
        for (int b = 0; b < 2; ++b)
#pragma unroll
            for (int m = 0; m < 4; ++m)
#pragma unroll
                for (int n = 0; n < 2; ++n) acc[a][b][m][n] = (f32x4){0.f, 0.f, 0.f, 0.f};
    bf16x8 At[4][2], B0[2][2], B1[2][2];
    const char* cA = (const char*)g.A + (size_t)cur.pm * tstep; const char* cB = (const char*)g.Bt + (size_t)cur.pn * tstep;
    S.a_ready(cur);
    if constexpr (SP2) {
        PG8_STAGE(PG8_SB(0, 0), cB, voffB); PG8_STAGE(PG8_SB(0, 1), cB + hstep, voffB); PG8_STAGE(PG8_SA(0, 0), cA, voffA); PG8_STAGE(PG8_SA(0, 1), cA + hstep, voffA);
        if (wr == 1) PG8_BAR;
        PG8_WAIT_V(2); PG8_BAR;
        PG8_STAGE(PG8_SB(1, 0), cB + kstep, voffB); PG8_STAGE(PG8_SA(1, 0), cA + kstep, voffA); PG8_STAGE(PG8_SB(1, 1), cB + hstep + kstep, voffB);
        PG8_WAIT_V(6); PG8_BAR;
    } else {
        PG8_STAGE(PG8_SB(0, 0), cB, voffB); PG8_STAGE(PG8_SA(0, 0), cA, voffA); PG8_STAGE(PG8_SB(0, 1), cB + hstep, voffB); PG8_STAGE(PG8_SA(0, 1), cA + hstep, voffA);
        if (wr == 1) PG8_BAR;
        PG8_WAIT_V(4); PG8_BAR;
        PG8_STAGE(PG8_SB(1, 0), cB + kstep, voffB); PG8_STAGE(PG8_SA(1, 0), cA + kstep, voffA); PG8_STAGE(PG8_SB(1, 1), cB + hstep + kstep, voffB);
        PG8_WAIT_V(6); PG8_BAR;
    }
    for (;;) {
        const bool has_next = S.next(ui + 1, nxt);
        const char* nA = has_next ? (const char*)g.A + (size_t)nxt.pm * tstep : cA; const char* nB = has_next ? (const char*)g.Bt + (size_t)nxt.pn * tstep : cB;
        for (int t = 0; t < nt; t += 2) {
            const bool last = (t == nt - 2);
            const char* a1 = cA + (size_t)(t + 1) * kstep;
            const char* a2 = last ? nA : cA + (size_t)(t + 2) * kstep; const char* b2 = last ? nB : cB + (size_t)(t + 2) * kstep;
            const char* a3 = a2 + kstep; const char* b3 = b2 + kstep;
            if (last && has_next) S.a_ready(nxt);
            if constexpr (SP2) {
            PG8_LDB(B0, 0, 0); PG8_LDB(B1, 0, 1); PG8_SCHED; PG8_LDA(At, 0, 0); PG8_STAGE(PG8_SA(1, 1), a1 + hstep, voffA);
            PG8_WAIT_V(8); PG8_WAIT_L(0); PG8_BAR; PG8_MMA(0, 0, At, B0); PG8_MMA(0, 1, At, B1); PG8_BAR; PG8_SCHED;
            PG8_LDA(At, 0, 1); PG8_STAGE(PG8_SB(0, 0), b2, voffB); PG8_STAGE(PG8_SB(0, 1), b2 + hstep, voffB); PG8_STAGE(PG8_SA(0, 0), a2, voffA);
            PG8_WAIT_V(8); PG8_WAIT_L(0); PG8_BAR; PG8_MMA(1, 0, At, B0); PG8_MMA(1, 1, At, B1); PG8_BAR; PG8_SCHED;
            PG8_LDB(B0, 1, 0); PG8_LDB(B1, 1, 1); PG8_SCHED; PG8_LDA(At, 1, 0); PG8_STAGE(PG8_SA(0, 1), a2 + hstep, voffA);
            PG8_WAIT_V(8); PG8_WAIT_L(0); PG8_BAR; PG8_MMA(0, 0, At, B0); PG8_MMA(0, 1, At, B1); PG8_BAR; PG8_SCHED;
            PG8_LDA(At, 1, 1); PG8_STAGE(PG8_SB(1, 0), b3, voffB); PG8_STAGE(PG8_SB(1, 1), b3 + hstep, voffB); PG8_STAGE(PG8_SA(1, 0), a3, voffA);
            PG8_WAIT_V(8); PG8_WAIT_L(0); PG8_BAR; PG8_MMA(1, 0, At, B0); PG8_MMA(1, 1, At, B1); PG8_BAR; PG8_SCHED;
            } else {
            PG8_LDB(B0, 0, 0); PG8_SCHED; PG8_LDA(At, 0, 0); PG8_STAGE(PG8_SA(1, 1), a1 + hstep, voffA);
            PG8_WAIT_L(8); PG8_BAR; PG8_WAIT_L(0); PG8_MMA(0, 0, At, B0); PG8_BAR; PG8_SCHED;
            PG8_LDB(B1, 0, 1); PG8_STAGE(PG8_SB(0, 0), b2, voffB);
            PG8_BAR; PG8_WAIT_L(0); PG8_MMA(0, 1, At, B1); PG8_BAR;
            PG8_LDA(At, 0, 1); PG8_STAGE(PG8_SA(0, 0), a2, voffA);
            PG8_BAR; PG8_WAIT_L(0); PG8_MMA(1, 0, At, B0); PG8_BAR; PG8_SCHED;
            PG8_STAGE(PG8_SB(0, 1), b2 + hstep, voffB);
            PG8_WAIT_V(6); PG8_BAR; PG8_MMA(1, 1, At, B1); PG8_BAR;
            PG8_LDB(B0, 1, 0); PG8_SCHED; PG8_LDA(At, 1, 0); PG8_STAGE(PG8_SA(0, 1), a2 + hstep, voffA);
            PG8_WAIT_L(8); PG8_BAR; PG8_WAIT_L(0); PG8_MMA(0, 0, At, B0); PG8_BAR; PG8_SCHED;
            PG8_LDB(B1, 1, 1); PG8_STAGE(PG8_SB(1, 0), b3, voffB);
            PG8_BAR; PG8_WAIT_L(0); PG8_MMA(0, 1, At, B1); PG8_BAR;
            PG8_LDA(At, 1, 1); PG8_STAGE(PG8_SA(1, 0), a3, voffA);
            PG8_BAR; PG8_WAIT_L(0); PG8_MMA(1, 0, At, B0); PG8_BAR; PG8_SCHED;
            PG8_STAGE(PG8_SB(1, 1), b3 + hstep, voffB);
            PG8_WAIT_V(6); PG8_BAR; PG8_MMA(1, 1, At, B1); PG8_BAR;
            }
        }
        if constexpr (ALIGN_EPI) { if (wr == 0) PG8_BAR; }
        if constexpr (!Epi::AFTER_DRAIN) { E(acc, cur, wr, wc, fr, fq); S.done(cur); }
        if (!has_next) break;
#pragma unroll
        for (int a = 0; a < 2; ++a)
#pragma unroll
            for (int b = 0; b < 2; ++b)
#pragma unroll
                for (int m = 0; m < 4; ++m)
#pragma unroll
                    for (int n = 0; n < 2; ++n) acc[a][b][m][n] = (f32x4){0.f, 0.f, 0.f, 0.f};
        cur = nxt; cA = nA; cB = nB; ++ui;
        if constexpr (ALIGN_EPI) { if (wr == 1) PG8_BAR; }
    }
    PG8_WAIT_V(0);
    if constexpr (!ALIGN_EPI) { if (wr == 0) PG8_BAR; }
    PG8_BAR;
    if constexpr (Epi::AFTER_DRAIN) { E.fused(acc, cur, wr, wc, fr, fq, lds, wid, lane); S.done(cur); }
#undef PG8_SA
#undef PG8_SB
#undef PG8_STAGE
#undef PG8_LDA
#undef PG8_LDB
#undef PG8_MMA
#undef PG8_WAIT_V
#undef PG8_WAIT_L
#undef PG8_BAR
#undef PG8_SCHED
}
}

#define LAS __attribute__((address_space(3)))
typedef unsigned short bf16_t;
typedef float f32x4 __attribute__((ext_vector_type(4)));
typedef unsigned u32x4 __attribute__((ext_vector_type(4)));
typedef unsigned u32x2 __attribute__((ext_vector_type(2)));
constexpr int DM = 1024, NPT = 16384, NST = 512, MT = NPT + NST, TSEQ = 2048;
constexpr int DFF = 2816, NUP = 5632, DIN = 2816, NSH = 1792, DRW = 512, DCV = 512, CWID = 31, NLR = 1536, KLR = 256, NADA = 9216;
constexpr float RMS_EPS = 1e-6f, LN_EPS = 1e-5f, GN_EPS = 64e-5f, LOG2E = 1.4426950408889634f;
constexpr size_t O_Y = 0, O_WKVP = 17301504, O_SHP = 17563648, O_CVP = 17577984, O_WKVS = 17700864, O_SHS = 21895168, O_CVS = 22124544, O_END = 24090624;
constexpr size_t MiB = 1u << 20;
constexpr size_t WS_ADA = 0;
constexpr size_t WS_SC = 9437184;
constexpr size_t WS_WADA = 10 * MiB;
constexpr size_t WS_WUP1 = 28 * MiB;
constexpr size_t WS_WDN1 = 39 * MiB;
constexpr size_t WS_WIN = WS_WDN1 + 5767168;
constexpr size_t WS_WLR = 50 * MiB;
constexpr size_t WS_WOUT = 51 * MiB;
constexpr size_t WS_WUP2 = 53 * MiB;
constexpr size_t WS_WDN2 = 64 * MiB;
constexpr size_t WS_L = 70 * MiB;
constexpr size_t WS_H = 79 * MiB;
constexpr size_t WS_D = 112 * MiB;
constexpr size_t WS_ACT = 162 * MiB;
constexpr size_t WS_END = WS_ACT + (size_t)MT * DFF * 2;
constexpr size_t WS_CTL = 253 * MiB, CTL_BYTES = 16384;
static_assert(WS_END <= WS_CTL && WS_CTL + CTL_BYTES <= 256 * MiB, "ws map");
constexpr int LDS_CTL_OFF = 131072;
constexpr int LDS_BYTES = 147456;

struct KArgs { const float* in[32]; float* out; unsigned char* ws; };
typedef const __attribute__((address_space(4))) KArgs* KP;

__device__ __forceinline__ float bf_lo(unsigned u) { return __builtin_bit_cast(float, u << 16); }
__device__ __forceinline__ float bf_hi(unsigned u) { return __builtin_bit_cast(float, u & 0xffff0000u); }
__device__ __forceinline__ float bf1(bf16_t b) { return __builtin_bit_cast(float, ((unsigned)b) << 16); }
__device__ __forceinline__ unsigned pk2(float lo, float hi) { return pg8::cvt_pk_bf16(lo, hi); }
__device__ __forceinline__ float sigm(float x) { return pg8::fast_sigmoid(x); }
__device__ __forceinline__ float tanh_fast(float x) { const float e = __builtin_amdgcn_exp2f(2.0f * LOG2E * x); return 1.0f - 2.0f * __builtin_amdgcn_rcpf(e + 1.0f); }
__device__ __forceinline__ float rsq(float x) { return 1.0f / sqrtf(x); }
__device__ __forceinline__ void ld8bf(const bf16_t* p, float (&o)[8]) { const u32x4 r = *(const u32x4*)p;
    o[0] = bf_lo(r.x); o[1] = bf_hi(r.x); o[2] = bf_lo(r.y); o[3] = bf_hi(r.y); o[4] = bf_lo(r.z); o[5] = bf_hi(r.z); o[6] = bf_lo(r.w); o[7] = bf_hi(r.w); }
__device__ __forceinline__ void ld8f(const float* p, float (&o)[8]) { const f32x4 a = *(const f32x4*)p, b = *(const f32x4*)(p + 4);
    o[0] = a.x; o[1] = a.y; o[2] = a.z; o[3] = a.w; o[4] = b.x; o[5] = b.y; o[6] = b.z; o[7] = b.w; }
__device__ __forceinline__ f32x4 ld4bf(const bf16_t* p) { const u32x2 r = *(const u32x2*)p; return (f32x4){bf_lo(r.x), bf_hi(r.x), bf_lo(r.y), bf_hi(r.y)}; }
__device__ __forceinline__ float wave_sum(float v) {
#pragma unroll
    for (int o = 1; o < 64; o <<= 1) v += __shfl_xor(v, o);
    return v;
}
template <int CTRL> __device__ __forceinline__ float dpp_mov(float x) { return __builtin_bit_cast(float, __builtin_amdgcn_update_dpp(0, __builtin_bit_cast(int, x), CTRL, 0xF, 0xF, true)); }
__device__ __forceinline__ float red8(float x) { x += dpp_mov<0xB1>(x); x += dpp_mov<0x4E>(x); x += dpp_mov<0x141>(x); return x; }
__device__ __forceinline__ float red16(float x) { x = red8(x); x += dpp_mov<0x140>(x); return x; }
__device__ __forceinline__ int batch_of_row(int m) { return m < NPT ? (m >> 11) : 8 + ((m - NPT) >> 2); }
#define LDS_WAIT() asm volatile("s_waitcnt lgkmcnt(0)" ::: "memory")
#define LBAR() do { asm volatile("s_waitcnt lgkmcnt(0)" ::: "memory"); __builtin_amdgcn_s_barrier(); asm volatile("" ::: "memory"); } while (0)

__device__ __forceinline__ void p0_transpose_item(const float* W, int K, int N, bf16_t* WT, int swi, LAS float* scr, int item, int lane) {
    const int nblk = N / 32, kb = item / nblk, nb = item % nblk, k0 = 64 * kb, n0 = 32 * nb;
    int s0 = n0;
    if (swi) { const int pn = n0 >> 8, bj = (n0 >> 7) & 1, j0 = n0 & 127; s0 = bj * DFF + 128 * pn + j0; }
#pragma unroll 8
    for (int i = 0; i < 32; ++i) { const int kk = 2 * i + (lane >> 5); scr[kk * 33 + (lane & 31)] = W[(size_t)(k0 + kk) * N + s0 + (lane & 31)]; }
    LDS_WAIT(); asm volatile("" ::: "memory");
    const int c = lane & 7;
#pragma unroll
    for (int j = 0; j < 4; ++j) { const int n = (lane >> 3) + 8 * j; const LAS float* s = scr + (8 * c) * 33 + n;
        u32x4 o; o.x = pk2(s[0 * 33], s[1 * 33]); o.y = pk2(s[2 * 33], s[3 * 33]); o.z = pk2(s[4 * 33], s[5 * 33]); o.w = pk2(s[6 * 33], s[7 * 33]);
        *(u32x4*)(WT + (size_t)(n0 + n) * K + k0 + 8 * c) = o; }
    LDS_WAIT(); asm volatile("" ::: "memory");
}
__device__ __forceinline__ void p0_prologue(KP A, LAS unsigned char* lds, int tid, int wave, int lane) {
    LAS float* scr = (LAS float*)(lds + wave * 16384);
    const int gw = blockIdx.x * 8 + wave, NGW = gridDim.x * 8;
    unsigned char* ws = A->ws;
    constexpr int I_ADA = 16 * (NADA / 32), I_UP = 16 * (NUP / 32), I_DN = (DFF / 64) * (DM / 32), I_IN = 16 * (DIN / 32), I_OUT = 16 * (DM / 32);
    constexpr int NITEMS = I_ADA + 2 * I_UP + 2 * I_DN + I_IN + I_OUT;
    for (int it = gw; it < NITEMS; it += NGW) {
        int r = it;
        if (r < I_ADA) { p0_transpose_item(A->in[7], DM, NADA, (bf16_t*)(ws + WS_WADA), 0, scr, r, lane); continue; } r -= I_ADA;
        if (r < I_UP) { p0_transpose_item(A->in[11], DM, NUP, (bf16_t*)(ws + WS_WUP1), 1, scr, r, lane); continue; } r -= I_UP;
        if (r < I_UP) { p0_transpose_item(A->in[30], DM, NUP, (bf16_t*)(ws + WS_WUP2), 1, scr, r, lane); continue; } r -= I_UP;
        if (r < I_DN) { p0_transpose_item(A->in[12], DFF, DM, (bf16_t*)(ws + WS_WDN1), 0, scr, r, lane); continue; } r -= I_DN;
        if (r < I_DN) { p0_transpose_item(A->in[31], DFF, DM, (bf16_t*)(ws + WS_WDN2), 0, scr, r, lane); continue; } r -= I_DN;
        if (r < I_IN) { p0_transpose_item(A->in[13], DM, DIN, (bf16_t*)(ws + WS_WIN), 0, scr, r, lane); continue; } r -= I_IN;
        p0_transpose_item(A->in[29], DM, DM, (bf16_t*)(ws + WS_WOUT), 0, scr, r, lane);
    }
    const int gt = blockIdx.x * 512 + tid, NGT = gridDim.x * 512;
    bf16_t* wlr = (bf16_t*)(ws + WS_WLR);
    for (int i = gt; i < NLR * KLR; i += NGT) {
        const int n = i >> 8, k = i & 255; float v = 0.f;
        if (n < 512) { if (k < 64) v = A->in[16][k * 512 + n]; }
        else if (n < 1024) { if (k >= 64 && k < 128) v = A->in[18][(k - 64) * 512 + (n - 512)]; }
        else { if (k >= 128) v = A->in[19][(k - 128) * 512 + (n - 1024)]; }
        wlr[i] = (bf16_t)(pk2(v, 0.f) & 0xffffu);
    }
    bf16_t* sc = (bf16_t*)(ws + WS_SC);
    for (int i = gt; i < 256 * DM; i += NGT) {
        const int b = i >> 10, c = i & 1023; float v = 0.f;
        if (b < 8) v = A->in[2][b * DM + c]; else if (b < 136) v = A->in[3][(b - 8) * DM + c];
        v = v * sigm(v);
        sc[i] = (bf16_t)(pk2(v, 0.f) & 0xffffu);
    }
}

template <int MODE>
__device__ __forceinline__ void row_pass(KP A, int wave, int lane, int sub_prev, float res_w, int sub_next) {
    const int gw = blockIdx.x * 8 + wave, NGW = gridDim.x * 8;
    const float* ada = (const float*)(A->ws + WS_ADA);
    const bf16_t* D = (const bf16_t*)(A->ws + WS_D);
    bf16_t* H = (bf16_t*)(A->ws + WS_H);
    const float* gpre = A->in[9] + sub_next * DM; const float* gpost = A->in[10] + sub_prev * DM;
    for (int m = gw; m < MT; m += NGW) {
        const float* adab = ada + (size_t)batch_of_row(m) * NADA;
        float* xo = A->out + (size_t)m * DM;
        const float* xi = (MODE == 0 || sub_prev == 0) ? (m < NPT ? A->in[0] + (size_t)m * DM : A->in[1] + (size_t)(m - NPT) * DM) : xo;
        f32x4 v[4];
#pragma unroll
        for (int j = 0; j < 4; ++j) v[j] = *(const f32x4*)(xi + 4 * lane + 256 * j);
        if (MODE >= 1) {
            f32x4 d[4]; float ss = 0.f;
#pragma unroll
            for (int j = 0; j < 4; ++j) { d[j] = ld4bf(D + (size_t)m * DM + 4 * lane + 256 * j); ss += (d[j].x * d[j].x + d[j].y * d[j].y) + (d[j].z * d[j].z + d[j].w * d[j].w); }
            const float rs = rsq(wave_sum(ss) * (1.0f / DM) + RMS_EPS);
#pragma unroll
            for (int j = 0; j < 4; ++j) { const int col = 4 * lane + 256 * j;
                const f32x4 g = *(const f32x4*)(gpost + col), gt = *(const f32x4*)(adab + (sub_prev * 3 + 2) * DM + col);
                v[j] = v[j] + (res_w * gt) * ((d[j] * rs) * g);
                *(f32x4*)(xo + col) = v[j]; }
        }
        if (MODE <= 1) {
            float ss = 0.f;
#pragma unroll
            for (int j = 0; j < 4; ++j) ss += (v[j].x * v[j].x + v[j].y * v[j].y) + (v[j].z * v[j].z + v[j].w * v[j].w);
            const float rs = rsq(wave_sum(ss) * (1.0f / DM) + RMS_EPS);
#pragma unroll
            for (int j = 0; j < 4; ++j) { const int col = 4 * lane + 256 * j;
                const f32x4 g = *(const f32x4*)(gpre + col), sc = *(const f32x4*)(adab + (sub_next * 3 + 1) * DM + col), sh = *(const f32x4*)(adab + (sub_next * 3 + 0) * DM + col);
                const f32x4 h = ((v[j] * rs) * g) * (1.0f + sc) + sh;
                u32x2 w; w.x = pk2(h.x, h.y); w.y = pk2(h.z, h.w);
                *(u32x2*)(H + (size_t)m * DM + col) = w; }
        }
    }
}

__device__ __forceinline__ void p7_lowrank_inputs(KP A, int wave, int lane) {
    const int gw = blockIdx.x * 8 + wave, NGW = gridDim.x * 8;
    const bf16_t* PROJ = (const bf16_t*)(A->ws + WS_ACT);
    bf16_t* L = (bf16_t*)(A->ws + WS_L);
    const float* mu = A->in[14];
    for (int m = gw; m < MT; m += NGW) {
        bool first, last; const float* st = nullptr; float* sho;
        if (m < NPT) { const int t = m & 2047; first = (t == 0); last = (t == 2047); sho = A->out + O_SHP + (size_t)(m >> 11) * NSH; }
        else { const int ms = m - NPT, seq = ms >> 2, t = ms & 3; first = (t == 0); last = (t == 3); st = A->in[5] + (size_t)seq * NSH; sho = A->out + O_SHS + (size_t)seq * NSH; }
        const int col = 1536 + 4 * lane;
        const f32x4 p = ld4bf(PROJ + (size_t)m * DIN + col);
        f32x4 pv = (f32x4){0.f, 0.f, 0.f, 0.f};
        if (!first) pv = ld4bf(PROJ + (size_t)(m - 1) * DIN + col); else if (st) pv = *(const f32x4*)(st + col);
        const f32x4 mm = *(const f32x4*)(mu + col);
        const f32x4 xs = p + (pv - p) * mm;
        f32x4 o;
        if (lane < 16) o = (f32x4){tanh_fast(xs.x), tanh_fast(xs.y), tanh_fast(xs.z), tanh_fast(xs.w)};
        else if (lane < 32) o = xs;
        else o = (f32x4){sigm(xs.x), sigm(xs.y), sigm(xs.z), sigm(xs.w)};
        u32x2 w; w.x = pk2(o.x, o.y); w.y = pk2(o.z, o.w);
        *(u32x2*)(L + (size_t)m * KLR + 4 * lane) = w;
        if (last) { for (int cc = 4 * lane; cc < NSH; cc += 256) *(f32x4*)(sho + cc) = ld4bf(PROJ + (size_t)m * DIN + cc); }
    }
}
__device__ __forceinline__ void conv_ln_store(KP A, LAS float* Z, int m0, int wave, int lane) {
    bf16_t* YZ = (bf16_t*)(A->ws + WS_H);
    float g[8], bb[8]; ld8f(A->in[27] + 8 * lane, g); ld8f(A->in[28] + 8 * lane, bb);
#pragma unroll
    for (int q = 0; q < 4; ++q) { const int tt = 4 * wave + q;
        const f32x4 a = *(const LAS f32x4*)(Z + tt * 512 + 8 * lane), b = *(const LAS f32x4*)(Z + tt * 512 + 8 * lane + 4);
        float z[8] = {a.x, a.y, a.z, a.w, b.x, b.y, b.z, b.w};
        float s = 0.f;
#pragma unroll
        for (int e = 0; e < 8; ++e) s += z[e];
        const float mean = wave_sum(s) * (1.0f / 512.0f); float qv = 0.f;
#pragma unroll
        for (int e = 0; e < 8; ++e) { z[e] -= mean; qv += z[e] * z[e]; }
        const float rs = rsq(wave_sum(qv) * (1.0f / 512.0f) + LN_EPS);
        float o[8];
#pragma unroll
        for (int e = 0; e < 8; ++e) { const float y = z[e] * rs * g[e] + bb[e]; o[e] = y * sigm(y); }
        u32x4 w; w.x = pk2(o[0], o[1]); w.y = pk2(o[2], o[3]); w.z = pk2(o[4], o[5]); w.w = pk2(o[6], o[7]);
        *(u32x4*)(YZ + (size_t)(m0 + tt) * DM + 512 + 8 * lane) = w; }
}
__device__ __forceinline__ void p7_conv(KP A, LAS unsigned char* lds, int tid, int wave, int lane) {
    const bf16_t* PROJ = (const bf16_t*)(A->ws + WS_ACT);
    LAS float* Z = (LAS float*)lds;
    const int c = tid;
    float w[CWID];
#pragma unroll
    for (int j = 0; j < CWID; ++j) w[j] = A->in[25][j * DCV + c];
    const float cb = A->in[26][c];
    for (int tile = blockIdx.x; tile < 512 + 16; tile += gridDim.x) {
        if (tile < 512) {
            const int b = tile >> 6, t0 = (tile & 63) * 32;
            const bf16_t* P = PROJ + (size_t)(b * TSEQ) * DIN + NSH + c;
            float u[62];
#pragma unroll
            for (int i = 0; i < 62; ++i) { const int t = t0 - 30 + i;
                if (t >= 0) { const float ua = bf1(P[(size_t)t * DIN]), ug = bf1(P[(size_t)t * DIN + DCV]); u[i] = ua * sigm(ug); } else u[i] = 0.f; }
#pragma unroll
            for (int t = 0; t < 32; ++t) { float acc = cb;
#pragma unroll
                for (int j = 0; j < CWID; ++j) acc += w[j] * u[t + j];
                Z[t * 512 + c] = acc; }
            if (t0 == TSEQ - 32) {
#pragma unroll
                for (int i = 0; i < 30; ++i) A->out[O_CVP + (size_t)(b * 30 + i) * DCV + c] = u[32 + i]; }
            __syncthreads();
            conv_ln_store(A, Z, b * TSEQ + t0, wave, lane);
            __syncthreads();
        } else {
            const int s0 = (tile - 512) * 8;
            for (int si = 0; si < 8; ++si) { const int seq = s0 + si;
                float f[34];
#pragma unroll
                for (int i = 0; i < 30; ++i) f[i] = A->in[6][(size_t)(seq * 30 + i) * DCV + c];
                const bf16_t* P = PROJ + (size_t)(NPT + seq * 4) * DIN + NSH + c;
#pragma unroll
                for (int t = 0; t < 4; ++t) { const float ua = bf1(P[(size_t)t * DIN]), ug = bf1(P[(size_t)t * DIN + DCV]); f[30 + t] = ua * sigm(ug); }
#pragma unroll
                for (int t = 0; t < 4; ++t) { float acc = cb;
#pragma unroll
                    for (int j = 0; j < CWID; ++j) acc += w[j] * f[t + j];
                    Z[(si * 4 + t) * 512 + c] = acc; }
#pragma unroll
                for (int i = 0; i < 30; ++i) A->out[O_CVS + (size_t)(seq * 30 + i) * DCV + c] = f[i + 4];
            }
            __syncthreads();
            conv_ln_store(A, Z, NPT + s0 * 4, wave, lane);
            __syncthreads();
        }
    }
}

constexpr int SC_R = 0, SC_W = 16384, SC_K = 32768, SC_A = 49152, SC_B = 65536, SC_V = 81920, SC_Y = 86016;
struct Slot { int m, seq, h, q; bool first, sample; };
__device__ __forceinline__ Slot slot_prompt(int item, int chunk, int s) { Slot x; x.seq = item >> 5; x.h = (item >> 2) & 7; x.q = item & 3; const int t = chunk * 64 + s; x.m = x.seq * TSEQ + t; x.first = (t == 0); x.sample = false; return x; }
__device__ __forceinline__ Slot slot_sample(int group, int s) { Slot x; const int i = group * 16 + (s >> 2), t = s & 3; x.seq = i >> 5; x.h = (i >> 2) & 7; x.q = i & 3; x.m = NPT + x.seq * 4 + t; x.first = (t == 0); x.sample = true; return x; }

__device__ __forceinline__ void lerp8(const bf16_t* PROJ, const float* st, const float* mu, const Slot& x, int col, float (&o)[8]) {
    float p[8], pv[8], mm[8];
    ld8bf(PROJ + (size_t)x.m * DIN + col, p);
    if (!x.first) ld8bf(PROJ + (size_t)(x.m - 1) * DIN + col, pv);
    else if (x.sample) ld8f(st + (size_t)x.seq * NSH + col, pv);
    else {
#pragma unroll
        for (int e = 0; e < 8; ++e) pv[e] = 0.f; }
    ld8f(mu + col, mm);
#pragma unroll
    for (int e = 0; e < 8; ++e) o[e] = p[e] + (pv[e] - p[e]) * mm[e];
}
__device__ __forceinline__ float rwkv_prep8(KP A, const Slot& x, int cg, float (&r)[8], float (&w)[8], float (&km)[8], float (&v)[8], float (&a)[8], float (&b)[8]) {
    const bf16_t* PROJ = (const bf16_t*)(A->ws + WS_ACT); const bf16_t* LR = (const bf16_t*)(A->ws + WS_D);
    const int gc = x.h * 64 + 8 * cg;
    float k[8];
    lerp8(PROJ, A->in[5], A->in[14], x, gc, r); lerp8(PROJ, A->in[5], A->in[14], x, 512 + gc, k); lerp8(PROJ, A->in[5], A->in[14], x, 1024 + gc, v);
    float dp[8], ip[8], w0[8], a0[8], kk_[8], ka[8], rk[8];
    ld8bf(LR + (size_t)x.m * NLR + gc, dp); ld8bf(LR + (size_t)x.m * NLR + 512 + gc, ip);
    ld8f(A->in[15] + gc, w0); ld8f(A->in[17] + gc, a0); ld8f(A->in[20] + gc, kk_); ld8f(A->in[21] + gc, ka); ld8f(A->in[22] + gc, rk);
    float ss = 0.f, bon = 0.f, ic[8], kv[8];
#pragma unroll
    for (int e = 0; e < 8; ++e) {
        const float sg = sigm(w0[e] + dp[e]);
        w[e] = __builtin_amdgcn_exp2f(-0.6065306597126334f * LOG2E * sg);
        ic[e] = sigm(a0[e] + ip[e]);
        kv[e] = k[e] * kk_[e]; ss += kv[e] * kv[e];
        km[e] = k[e] * (1.0f + (ic[e] - 1.0f) * ka[e]);
        bon += r[e] * km[e] * rk[e];
    }
    ss = red8(ss);
    const float inv = 1.0f / fmaxf(sqrtf(ss), 1e-12f);
#pragma unroll
    for (int e = 0; e < 8; ++e) { const float kn = kv[e] * inv; a[e] = -kn; b[e] = kn * ic[e]; }
    return bon;
}
__device__ __forceinline__ void scan_prep_store(KP A, LAS unsigned char* lds, const Slot& x, int s, int cg) {
    float r[8], w[8], km[8], v[8], a[8], b[8];
    (void)rwkv_prep8(A, x, cg, r, w, km, v, a, b);
    const int o = (s * 64 + 8 * cg) * 4;
    *(LAS f32x4*)(lds + SC_R + o) = (f32x4){r[0], r[1], r[2], r[3]}; *(LAS f32x4*)(lds + SC_R + o + 16) = (f32x4){r[4], r[5], r[6], r[7]};
    *(LAS f32x4*)(lds + SC_W + o) = (f32x4){w[0], w[1], w[2], w[3]}; *(LAS f32x4*)(lds + SC_W + o + 16) = (f32x4){w[4], w[5], w[6], w[7]};
    *(LAS f32x4*)(lds + SC_K + o) = (f32x4){km[0], km[1], km[2], km[3]}; *(LAS f32x4*)(lds + SC_K + o + 16) = (f32x4){km[4], km[5], km[6], km[7]};
    *(LAS f32x4*)(lds + SC_A + o) = (f32x4){a[0], a[1], a[2], a[3]}; *(LAS f32x4*)(lds + SC_A + o + 16) = (f32x4){a[4], a[5], a[6], a[7]};
    *(LAS f32x4*)(lds + SC_B + o) = (f32x4){b[0], b[1], b[2], b[3]}; *(LAS f32x4*)(lds + SC_B + o + 16) = (f32x4){b[4], b[5], b[6], b[7]};
    if ((cg >> 1) == x.q) { const int ov = (s * 16 + (cg & 1) * 8) * 4;
        *(LAS f32x4*)(lds + SC_V + ov) = (f32x4){v[0], v[1], v[2], v[3]}; *(LAS f32x4*)(lds + SC_V + ov + 16) = (f32x4){v[4], v[5], v[6], v[7]}; }
}
__device__ __forceinline__ void scan_step(LAS unsigned char* lds, int s, int row16, int kq, f32x4& S) {
    const int o = (s * 64 + 4 * kq) * 4;
    const f32x4 a = *(const LAS f32x4*)(lds + SC_A + o), w = *(const LAS f32x4*)(lds + SC_W + o), b = *(const LAS f32x4*)(lds + SC_B + o),
                k = *(const LAS f32x4*)(lds + SC_K + o), r = *(const LAS f32x4*)(lds + SC_R + o);
    const float vv = *(const LAS float*)(lds + SC_V + (s * 16 + row16) * 4);
    float sa = (S.x * a.x + S.y * a.y) + (S.z * a.z + S.w * a.w);
    const f32x4 pre = S * w + vv * k;
    sa = red16(sa);
    S = pre + sa * b;
    float y = (S.x * r.x + S.y * r.y) + (S.z * r.z + S.w * r.w);
    y = red16(y);
    if (kq == 0) *(LAS float*)(lds + SC_Y + (s * 16 + row16) * 4) = y;
}
__device__ __forceinline__ void scan_store_y(KP A, LAS unsigned char* lds, const Slot& x, int s, int pr) {
    bf16_t* YZ = (bf16_t*)(A->ws + WS_H);
    const float y0 = *(const LAS float*)(lds + SC_Y + (s * 16 + 2 * pr) * 4), y1 = *(const LAS float*)(lds + SC_Y + (s * 16 + 2 * pr + 1) * 4);
    *(unsigned*)(YZ + (size_t)x.m * DM + x.h * 64 + x.q * 16 + 2 * pr) = pk2(y0, y1);
}

struct Raw { u32x4 pr, pk, pv, qr, qk, qv, dp, ip; };
struct Par { float mr[8], mk[8], mv[8], w0[8], a0[8], kk[8], ka[8]; };
__device__ __forceinline__ void raw_load(KP A, int m, bool first, int gc, Raw& R) {
    const bf16_t* P = (const bf16_t*)(A->ws + WS_ACT) + (size_t)m * DIN + gc;
    R.pr = *(const u32x4*)P; R.pk = *(const u32x4*)(P + 512); R.pv = *(const u32x4*)(P + 1024);
    if (!first) { const bf16_t* Q = P - DIN; R.qr = *(const u32x4*)Q; R.qk = *(const u32x4*)(Q + 512); R.qv = *(const u32x4*)(Q + 1024); }
    else { R.qr = (u32x4){0u, 0u, 0u, 0u}; R.qk = R.qr; R.qv = R.qr; }
    const bf16_t* Lp = (const bf16_t*)(A->ws + WS_D) + (size_t)m * NLR + gc;
    R.dp = *(const u32x4*)Lp; R.ip = *(const u32x4*)(Lp + 512);
}
__device__ __forceinline__ void unpk8(const u32x4 r, float (&o)[8]) { o[0] = bf_lo(r.x); o[1] = bf_hi(r.x); o[2] = bf_lo(r.y); o[3] = bf_hi(r.y); o[4] = bf_lo(r.z); o[5] = bf_hi(r.z); o[6] = bf_lo(r.w); o[7] = bf_hi(r.w); }
__device__ __forceinline__ void prep_store_raw(LAS unsigned char* lds, const Raw& R, const Par& P, int s, int cg, int q) {
    float p[8], pv[8], r[8], k[8], v[8], dp[8], ip[8], w[8], km[8], a[8], b[8], ic[8], kv[8];
    unpk8(R.pr, p); unpk8(R.qr, pv);
#pragma unroll
    for (int e = 0; e < 8; ++e) r[e] = p[e] + (pv[e] - p[e]) * P.mr[e];
    unpk8(R.pk, p); unpk8(R.qk, pv);
#pragma unroll
    for (int e = 0; e < 8; ++e) k[e] = p[e] + (pv[e] - p[e]) * P.mk[e];
    unpk8(R.pv, p); unpk8(R.qv, pv);
#pragma unroll
    for (int e = 0; e < 8; ++e) v[e] = p[e] + (pv[e] - p[e]) * P.mv[e];
    unpk8(R.dp, dp); unpk8(R.ip, ip);
    float ss = 0.f;
#pragma unroll
    for (int e = 0; e < 8; ++e) {
        const float sg = sigm(P.w0[e] + dp[e]);
        w[e] = __builtin_amdgcn_exp2f(-0.6065306597126334f * LOG2E * sg);
        ic[e] = sigm(P.a0[e] + ip[e]);
        kv[e] = k[e] * P.kk[e]; ss += kv[e] * kv[e];
        km[e] = k[e] * (1.0f + (ic[e] - 1.0f) * P.ka[e]);
    }
    ss = red8(ss);
    const float inv = 1.0f / fmaxf(sqrtf(ss), 1e-12f);
#pragma unroll
    for (int e = 0; e < 8; ++e) { const float kn = kv[e] * inv; a[e] = -kn; b[e] = kn * ic[e]; }
    const int o = (s * 64 + 8 * cg) * 4;
    *(LAS f32x4*)(lds + SC_R + o) = (f32x4){r[0], r[1], r[2], r[3]}; *(LAS f32x4*)(lds + SC_R + o + 16) = (f32x4){r[4], r[5], r[6], r[7]};
    *(LAS f32x4*)(lds + SC_W + o) = (f32x4){w[0], w[1], w[2], w[3]}; *(LAS f32x4*)(lds + SC_W + o + 16) = (f32x4){w[4], w[5], w[6], w[7]};
    *(LAS f32x4*)(lds + SC_K + o) = (f32x4){km[0], km[1], km[2], km[3]}; *(LAS f32x4*)(lds + SC_K + o + 16) = (f32x4){km[4], km[5], km[6], km[7]};
    *(LAS f32x4*)(lds + SC_A + o) = (f32x4){a[0], a[1], a[2], a[3]}; *(LAS f32x4*)(lds + SC_A + o + 16) = (f32x4){a[4], a[5], a[6], a[7]};
    *(LAS f32x4*)(lds + SC_B + o) = (f32x4){b[0], b[1], b[2], b[3]}; *(LAS f32x4*)(lds + SC_B + o + 16) = (f32x4){b[4], b[5], b[6], b[7]};
    if ((cg >> 1) == q) { const int ov = (s * 16 + (cg & 1) * 8) * 4;
        *(LAS f32x4*)(lds + SC_V + ov) = (f32x4){v[0], v[1], v[2], v[3]}; *(LAS f32x4*)(lds + SC_V + ov + 16) = (f32x4){v[4], v[5], v[6], v[7]}; }
}
struct Ops { f32x4 a, w, b, k, r; float vv; };
__device__ __forceinline__ Ops ops_load(LAS unsigned char* lds, int s, int row16, int kq) {
    Ops x; const int o = (s * 64 + 4 * kq) * 4;
    x.a = *(const LAS f32x4*)(lds + SC_A + o); x.w = *(const LAS f32x4*)(lds + SC_W + o); x.b = *(const LAS f32x4*)(lds + SC_B + o);
    x.k = *(const LAS f32x4*)(lds + SC_K + o); x.r = *(const LAS f32x4*)(lds + SC_R + o);
    x.vv = *(const LAS float*)(lds + SC_V + (s * 16 + row16) * 4);
    return x;
}
__device__ __forceinline__ float fmul_s(float a, float b) { float d; asm("v_mul_f32 %0, %1, %2" : "=v"(d) : "v"(a), "v"(b)); return d; }
__device__ __forceinline__ float fadd_s(float a, float b) { float d; asm("v_add_f32 %0, %1, %2" : "=v"(d) : "v"(a), "v"(b)); return d; }
__device__ __forceinline__ float ffma_s(float a, float b, float c) { float d; asm("v_fma_f32 %0, %1, %2, %3" : "=v"(d) : "v"(a), "v"(b), "v"(c)); return d; }
__device__ __forceinline__ float ops_step(const Ops& x, f32x4& S) {
    float p0 = fmul_s(S.x, x.a.x), p1 = fmul_s(S.z, x.a.z);
    p0 = ffma_s(S.y, x.a.y, p0); p1 = ffma_s(S.w, x.a.w, p1);
    float sa = fadd_s(p0, p1);
    float t0 = fmul_s(x.vv, x.k.x), t1 = fmul_s(x.vv, x.k.y), t2 = fmul_s(x.vv, x.k.z), t3 = fmul_s(x.vv, x.k.w);
    sa = red16(sa);
    t0 = ffma_s(S.x, x.w.x, t0); t1 = ffma_s(S.y, x.w.y, t1); t2 = ffma_s(S.z, x.w.z, t2); t3 = ffma_s(S.w, x.w.w, t3);
    S.x = ffma_s(sa, x.b.x, t0); S.y = ffma_s(sa, x.b.y, t1); S.z = ffma_s(sa, x.b.z, t2); S.w = ffma_s(sa, x.b.w, t3);
    float q0 = fmul_s(S.x, x.r.x), q1 = fmul_s(S.z, x.r.z);
    q0 = ffma_s(S.y, x.r.y, q0); q1 = ffma_s(S.w, x.r.w, q1);
    return red16(fadd_s(q0, q1));
}
__device__ __forceinline__ void p9_scan(KP A, LAS unsigned char* lds, int tid, int wave, int lane) {
    const int s_of = tid >> 3, cg = tid & 7;
    const int w4 = wave & 3, row16 = 4 * w4 + (lane >> 4), kq = lane & 15;
    for (int item = blockIdx.x; item < 256; item += gridDim.x) {
        const int seq = item >> 5, h = (item >> 2) & 7, q = item & 3;
        const int m_base = seq * TSEQ;
        if (wave < 4) {
            f32x4 S = (f32x4){0.f, 0.f, 0.f, 0.f};
            LBAR();
            for (int c = 0; c < 64; ++c) {
                const int s0 = (c & 1) * 32;
                Ops cur = ops_load(lds, s0, row16, kq);
#pragma unroll 4
                for (int s = 0; s < 32; ++s) {
                    const int sn = s0 + (s < 31 ? s + 1 : s);
                    const Ops nxt = ops_load(lds, sn, row16, kq);
                    const float y = ops_step(cur, S);
                    if (kq == 0) *(LAS float*)(lds + SC_Y + ((s0 + s) * 16 + row16) * 4) = y;
                    cur = nxt;
                }
                LBAR();
            }
            *(f32x4*)(A->out + O_WKVP + ((size_t)(seq * 8 + h) * 64 + q * 16 + row16) * 64 + 4 * kq) = S;
        } else {
            const int pt = tid - 256, sl = pt >> 3, pcg = pt & 7, gc = h * 64 + 8 * pcg;
            Par P;
            ld8f(A->in[14] + gc, P.mr); ld8f(A->in[14] + 512 + gc, P.mk); ld8f(A->in[14] + 1024 + gc, P.mv);
            ld8f(A->in[15] + gc, P.w0); ld8f(A->in[17] + gc, P.a0); ld8f(A->in[20] + gc, P.kk); ld8f(A->in[21] + gc, P.ka);
            bf16_t* YZ = (bf16_t*)(A->ws + WS_H);
            Raw R;
            raw_load(A, m_base + sl, sl == 0, gc, R);
            prep_store_raw(lds, R, P, sl, pcg, q);
            raw_load(A, m_base + 32 + sl, false, gc, R);
            LBAR();
            for (int c = 0; c < 64; ++c) {
                Raw Rn = R;
                if (c + 2 < 64) raw_load(A, m_base + (c + 2) * 32 + sl, false, gc, Rn);
                if (c >= 1) {
                    const int sb = ((c - 1) & 1) * 32 + sl;
                    const float y0 = *(const LAS float*)(lds + SC_Y + (sb * 16 + 2 * pcg) * 4), y1 = *(const LAS float*)(lds + SC_Y + (sb * 16 + 2 * pcg + 1) * 4);
                    *(unsigned*)(YZ + (size_t)(m_base + (c - 1) * 32 + sl) * DM + h * 64 + q * 16 + 2 * pcg) = pk2(y0, y1);
                }
                if (c + 1 < 64) prep_store_raw(lds, R, P, ((c + 1) & 1) * 32 + sl, pcg, q);
                R = Rn;
                LBAR();
            }
            { const int sb = 32 + sl;
              const float y0 = *(const LAS float*)(lds + SC_Y + (sb * 16 + 2 * pcg) * 4), y1 = *(const LAS float*)(lds + SC_Y + (sb * 16 + 2 * pcg + 1) * 4);
              *(unsigned*)(YZ + (size_t)(m_base + 63 * 32 + sl) * DM + h * 64 + q * 16 + 2 * pcg) = pk2(y0, y1); }
        }
        __syncthreads();
    }
    for (int grp = blockIdx.x; grp < 256; grp += gridDim.x) {
        const Slot x = slot_sample(grp, s_of);
        scan_prep_store(A, lds, x, s_of, cg);
        const int half = wave >> 2;
        f32x4 S[8];
#pragma unroll
        for (int j = 0; j < 8; ++j) { const int i = grp * 16 + half * 8 + j, seq = i >> 5, h = (i >> 2) & 7, q = i & 3;
            S[j] = *(const f32x4*)(A->in[4] + ((size_t)(seq * 8 + h) * 64 + q * 16 + row16) * 64 + 4 * kq); }
        __syncthreads();
#pragma unroll
        for (int j = 0; j < 8; ++j) {
#pragma unroll
            for (int t = 0; t < 4; ++t) scan_step(lds, (half * 8 + j) * 4 + t, row16, kq, S[j]);
        }
#pragma unroll
        for (int j = 0; j < 8; ++j) { const int i = grp * 16 + half * 8 + j, seq = i >> 5, h = (i >> 2) & 7, q = i & 3;
            *(f32x4*)(A->out + O_WKVS + ((size_t)(seq * 8 + h) * 64 + q * 16 + row16) * 64 + 4 * kq) = S[j]; }
        __syncthreads();
        scan_store_y(A, lds, x, s_of, cg);
        __syncthreads();
    }
}

__device__ __forceinline__ void p10_finalize(KP A, int wave, int lane) {
    const int gw = blockIdx.x * 8 + wave, NGW = gridDim.x * 8;
    bf16_t* YZ = (bf16_t*)(A->ws + WS_H); const bf16_t* LR = (const bf16_t*)(A->ws + WS_D);
    float lg[8], lb[8]; ld8f(A->in[23] + 8 * lane, lg); ld8f(A->in[24] + 8 * lane, lb);
    for (int m = gw; m < MT; m += NGW) {
        Slot x; x.m = m; x.h = lane >> 3; x.q = 0;
        if (m < NPT) { x.seq = m >> 11; x.first = ((m & 2047) == 0); x.sample = false; } else { const int ms = m - NPT; x.seq = ms >> 2; x.first = ((ms & 3) == 0); x.sample = true; }
        float r[8], w[8], km[8], v[8], a[8], b[8];
        float bon = rwkv_prep8(A, x, lane & 7, r, w, km, v, a, b);
        bon = red8(bon);
        float y[8], gt[8]; ld8bf(YZ + (size_t)m * DM + 8 * lane, y); ld8bf(LR + (size_t)m * NLR + 1024 + 8 * lane, gt);
        float s = 0.f;
#pragma unroll
        for (int e = 0; e < 8; ++e) s += y[e];
        const float mean = red8(s) * (1.0f / 64.0f); float qv = 0.f;
#pragma unroll
        for (int e = 0; e < 8; ++e) { y[e] -= mean; qv += y[e] * y[e]; }
        const float rs = rsq(red8(qv) * (1.0f / 64.0f) + GN_EPS);
        float o[8];
#pragma unroll
        for (int e = 0; e < 8; ++e) o[e] = (y[e] * rs * lg[e] + lb[e] + bon * v[e]) * gt[e];
        u32x4 wv; wv.x = pk2(o[0], o[1]); wv.y = pk2(o[2], o[3]); wv.z = pk2(o[4], o[5]); wv.w = pk2(o[6], o[7]);
        *(u32x4*)(YZ + (size_t)m * DM + 8 * lane) = wv;
    }
}

#define XB_TMO      128
#define XB_XCNT(j)  (256  + 64 * (j))
#define XB_XSUB(j)  (1280 + 64 * (j))
#define XB_XGEN(j)  (2304 + 64 * (j))
#define XB_TOP      3328
#define XB_TOPGEN   3392
#define XCD_BAR_WORDS 3456
#define XB_SPIN_CAP (1u << 18)

__device__ __forceinline__ unsigned xb_ld(unsigned* p)              { return __hip_atomic_load(p, __ATOMIC_RELAXED, __HIP_MEMORY_SCOPE_AGENT); }
__device__ __forceinline__ unsigned xb_add(unsigned* p, unsigned v) { return __hip_atomic_fetch_add(p, v, __ATOMIC_RELAXED, __HIP_MEMORY_SCOPE_AGENT); }
__device__ __forceinline__ unsigned xb_xcc_id() { return (unsigned)__builtin_amdgcn_s_getreg((3 << 11) | 20) & 0xFu; }
#define XB_SPIN(cond, bar) do { unsigned _sp = 0; while (cond) { __builtin_amdgcn_s_sleep(1); \
    if ((++_sp & 255u) == 0u) { if (xb_ld(&(bar)[XB_TMO])) break; if (_sp > XB_SPIN_CAP) { atomicAdd(&(bar)[XB_TMO], 1u); break; } } } } while (0)

struct XcdBarrier {
    unsigned* bar; unsigned x;
    volatile LAS unsigned* st;
};

__device__ __forceinline__ XcdBarrier xcd_barrier_post(unsigned* bar, volatile LAS unsigned* st) {
    XcdBarrier b; b.bar = bar; b.x = xb_xcc_id(); b.st = st;
    if (threadIdx.x == 0) (void)xb_add(&bar[XB_XCNT(b.x)], 1u);
    return b;
}
__device__ __forceinline__ void xcd_barrier_complete(unsigned* bar, unsigned x, unsigned& nloc, unsigned& nx) {
    const unsigned G = gridDim.x * gridDim.y * gridDim.z;
    unsigned sum, cnt, mine, sp = 0u;
    for (;;) {
        sum = 0u; cnt = 0u; mine = 0u;
#pragma unroll
        for (unsigned j = 0; j < 16; ++j) { const unsigned c = xb_ld(&bar[XB_XCNT(j)]); sum += c; cnt += (c > 0u) ? 1u : 0u; mine = (j == x) ? c : mine; }
        if (sum == G) break;
        __builtin_amdgcn_s_sleep(1);
        if ((++sp & 255u) == 0u) { if (xb_ld(&bar[XB_TMO])) break; if (sp > XB_SPIN_CAP) { atomicAdd(&bar[XB_TMO], 1u); break; } }
    }
    nloc = mine > 0u ? mine : 1u; nx = cnt > 0u ? cnt : 1u;
}

__device__ __forceinline__ void xcd_barrier(const XcdBarrier& b) {
    asm volatile("s_waitcnt vmcnt(0)" ::: "memory");
    __syncthreads();
    if (threadIdx.x == 0) {
        unsigned* bar = b.bar;
        __builtin_amdgcn_s_waitcnt(0);
        unsigned nloc = b.st[0], nx = b.st[1];
        if (nloc == 0u) { xcd_barrier_complete(bar, b.x, nloc, nx); b.st[0] = nloc; b.st[1] = nx; }
        const unsigned old = xb_add(&bar[XB_XSUB(b.x)], 1u);
        const unsigned gen = old / nloc;
        if (old + 1u == (gen + 1u) * nloc) {
            __builtin_amdgcn_fence(__ATOMIC_RELEASE, "agent");
            asm volatile("s_waitcnt vmcnt(0)" ::: "memory");
            const unsigned og = xb_add(&bar[XB_TOP], 1u);
            const unsigned tg = og / nx;
            if (og + 1u == (tg + 1u) * nx) xb_add(&bar[XB_TOPGEN], 1u);
            else XB_SPIN(xb_ld(&bar[XB_TOPGEN]) == tg, bar);
            __builtin_amdgcn_fence(__ATOMIC_ACQUIRE, "agent");
            xb_add(&bar[XB_XGEN(b.x)], 1u);
            asm volatile("s_waitcnt vmcnt(0)" ::: "memory");
        } else {
            XB_SPIN(xb_ld(&bar[XB_XGEN(b.x)]) == gen, bar);
            __builtin_amdgcn_fence(__ATOMIC_ACQUIRE, "agent");
            asm volatile("s_waitcnt vmcnt(0)" ::: "memory");
        }
    }
    __syncthreads();
}

#ifndef PHMASK
#define PHMASK 0xFFFF
#endif
constexpr int NPH = 16;
__global__ void __launch_bounds__(512) mk_fwd(KArgs A_unused) {
    extern __shared__ __attribute__((aligned(16))) unsigned char lds_raw[];
    LAS unsigned char* lds = (LAS unsigned char*)lds_raw;
    cg::grid_group grid = cg::this_grid();
#ifndef REPMASK
#define REPMASK 0
#endif
#ifndef XSYNC
#define XSYNC 0
#endif
    for (int k = 0; k < XSYNC; ++k) grid.sync();
    if (threadIdx.x < 2) ((volatile LAS unsigned*)(lds + LDS_CTL_OFF))[threadIdx.x] = 0u;
    __syncthreads();
    XcdBarrier bar = xcd_barrier_post((unsigned*)(((KP)__builtin_amdgcn_kernarg_segment_ptr())->ws + WS_CTL), (volatile LAS unsigned*)(lds + LDS_CTL_OFF));
    for (int phi = 0; phi < NPH + __builtin_popcount(REPMASK); ++phi) {
        int ph = phi;
        if (REPMASK) { int c = 0; ph = 0; for (int q = 0; q < NPH; ++q) { const int n = 1 + ((REPMASK >> q) & 1); if (phi >= c && phi < c + n) ph = q; c += n; } }
        KP kp = (KP)__builtin_amdgcn_kernarg_segment_ptr(); asm volatile("" : "+s"(kp));
        int tid_ = threadIdx.x; asm volatile("" : "+v"(tid_));
        const int tid = tid_, lane = tid & 63, wave = __builtin_amdgcn_readfirstlane(tid >> 6);
        const KP A = kp;
        unsigned char* ws = A->ws;
        switch (ph) {
        case 0: if constexpr ((PHMASK & 0x1) != 0) p0_prologue(A, lds, tid, wave, lane); break;
        case 1: if constexpr ((PHMASK & 0x2) != 0) { pg8::Gemm g{(const bf16_t*)(ws + WS_SC), (const bf16_t*)(ws + WS_WADA), 256, NADA, DM}; pg8::StaticOrder S; S.init(256, NADA, gridDim.x, blockIdx.x);
                  pg8::EpiF32B E{(float*)(ws + WS_ADA), NADA, A->in[8]};
                  pg8::gemm_phase<pg8::EpiF32B, pg8::StaticOrder, true, true>(lds, g, S, E); } break;
        case 2: if constexpr ((PHMASK & 0x4) != 0) row_pass<0>(A, wave, lane, 0, 0.f, 0); break;
        case 3: case 13: if constexpr ((PHMASK & 0x2008) != 0) { pg8::Gemm g{(const bf16_t*)(ws + WS_H), (const bf16_t*)(ws + (ph == 3 ? WS_WUP1 : WS_WUP2)), MT, NUP, DM}; pg8::StaticOrder S; S.init(MT, NUP, gridDim.x, blockIdx.x);
                  pg8::EpiSwiglu E{(bf16_t*)(ws + WS_ACT), DFF};
                  pg8::gemm_phase<pg8::EpiSwiglu, pg8::StaticOrder, true, true>(lds, g, S, E); } break;
        case 4: case 6: case 8: case 11: case 14: if constexpr ((PHMASK & 0x4950) != 0) {
                  pg8::Gemm g; pg8::EpiBf16P E;
                  if (ph == 4)       { g = pg8::Gemm{(const bf16_t*)(ws + WS_ACT), (const bf16_t*)(ws + WS_WDN1), MT, DM, DFF}; E = pg8::EpiBf16P{(bf16_t*)(ws + WS_D), DM}; }
                  else if (ph == 14) { g = pg8::Gemm{(const bf16_t*)(ws + WS_ACT), (const bf16_t*)(ws + WS_WDN2), MT, DM, DFF}; E = pg8::EpiBf16P{(bf16_t*)(ws + WS_D), DM}; }
                  else if (ph == 6)  { g = pg8::Gemm{(const bf16_t*)(ws + WS_H), (const bf16_t*)(ws + WS_WIN), MT, DIN, DM}; E = pg8::EpiBf16P{(bf16_t*)(ws + WS_ACT), DIN}; }
                  else if (ph == 8)  { g = pg8::Gemm{(const bf16_t*)(ws + WS_L), (const bf16_t*)(ws + WS_WLR), MT, NLR, KLR}; E = pg8::EpiBf16P{(bf16_t*)(ws + WS_D), NLR}; }
                  else               { g = pg8::Gemm{(const bf16_t*)(ws + WS_H), (const bf16_t*)(ws + WS_WOUT), MT, DM, DM}; E = pg8::EpiBf16P{(bf16_t*)(ws + WS_D), DM}; }
                  pg8::StaticOrder S; S.init(g.M, g.N, gridDim.x, blockIdx.x);
                  pg8::gemm_phase<pg8::EpiBf16P, pg8::StaticOrder, true, true>(lds, g, S, E); } break;
        case 5: if constexpr ((PHMASK & 0x20) != 0) row_pass<1>(A, wave, lane, 0, 0.5f, 1); break;
        case 7: if constexpr ((PHMASK & 0x80) != 0) { p7_lowrank_inputs(A, wave, lane); p7_conv(A, lds, tid, wave, lane); } break;
        case 9: if constexpr ((PHMASK & 0x200) != 0) p9_scan(A, lds, tid, wave, lane); break;
        case 10: if constexpr ((PHMASK & 0x400) != 0) p10_finalize(A, wave, lane); break;
        case 12: if constexpr ((PHMASK & 0x1000) != 0) row_pass<1>(A, wave, lane, 1, 1.0f, 2); break;
        case 15: if constexpr ((PHMASK & 0x8000) != 0) row_pass<2>(A, wave, lane, 2, 0.5f, 0); break;
        }
        if (ph == 0) grid.sync(); else if (phi + 1 < NPH + __builtin_popcount(REPMASK)) xcd_barrier(bar);
    }
}

extern "C" void kernel_launch(void* const* d_in, const int* in_sizes, int n_in, void* d_out, int out_size, void* d_ws, size_t ws_size, hipStream_t stream) {
    static int grid = 0;
    if (grid == 0) {
        if (n_in != 32 || out_size != (int)O_END || ws_size < WS_CTL + CTL_BYTES) { fprintf(stderr, "kernel_launch: unexpected shapes: n_in %d out %d ws %zu (need %zu)\n", n_in, out_size, ws_size, (size_t)WS_END); grid = -1; return; }
        int dev = 0, cus = 0, per_cu = 0;
        hipGetDevice(&dev);
        hipDeviceGetAttribute(&cus, hipDeviceAttributeMultiprocessorCount, dev);
        if (hipFuncSetAttribute((const void*)mk_fwd, hipFuncAttributeMaxDynamicSharedMemorySize, LDS_BYTES) != hipSuccess) { fprintf(stderr, "kernel_launch: hipFuncSetAttribute failed\n"); grid = -1; return; }
        if (hipOccupancyMaxActiveBlocksPerMultiprocessor(&per_cu, (const void*)mk_fwd, 512, LDS_BYTES) != hipSuccess || per_cu < 1) { fprintf(stderr, "kernel_launch: occupancy query failed (%d)\n", per_cu); (void)hipGetLastError(); per_cu = 1; }
        grid = cus * per_cu;
        fprintf(stderr, "kernel_launch: cus %d per_cu %d grid %d\n", cus, per_cu, grid);
    }
    if (grid < 0) return;
    KArgs a{};
    for (int i = 0; i < 32; ++i) a.in[i] = (const float*)d_in[i];
    a.out = (float*)d_out; a.ws = (unsigned char*)d_ws;
    if (hipMemsetAsync((char*)d_ws + WS_CTL, 0, CTL_BYTES, stream) != hipSuccess) { fprintf(stderr, "kernel_launch: memset failed\n"); return; }
    void* args[] = {&a};
    hipError_t e = hipLaunchCooperativeKernel((const void*)mk_fwd, dim3(grid), dim3(512), args, LDS_BYTES, stream);
    if (e != hipSuccess) fprintf(stderr, "kernel_launch: cooperative launch failed: %s (grid %d)\n", hipGetErrorString(e), grid);
}
```

```cpp
#include <hip/hip_runtime.h>
#include <hip/hip_cooperative_groups.h>
#include <cstdio>
#include <cstdint>
namespace cg = cooperative_groups;

namespace pg8 {
#define PG8_LAS __attribute__((address_space(3)))
typedef unsigned short bf16_t;
typedef short bf16x8 __attribute__((ext_vector_type(8)));
typedef float f32x4 __attribute__((ext_vector_type(4)));
typedef unsigned u32x4 __attribute__((ext_vector_type(4)));
constexpr int BM = 256, BK = 64, HALF = 128, HTB = HALF * BK * 2  , STAGE_BYTES = 8 * HTB, NXCD = 8, WGM = 8;

__host__ __device__ __forceinline__ int lds_byte(int r, int c) { const int st = (r >> 4) * 2 + (c >> 5), rr = r & 15, cc = c & 31, ob = rr * 64 + cc * 2; return st * 1024 + (ob ^ (((ob >> 9) & 1) << 5)); }
__host__ __device__ __forceinline__ void stage_rc(int b, int& R, int& C) { const int st = b / 1024, sb = b % 1024, swz = sb ^ (((sb >> 9) & 1) << 5); R = (st >> 1) * 16 + swz / 64; C = (st & 1) * 32 + (swz % 64) / 2; }
__host__ __device__ __forceinline__ int perm32(int rho) { const int n = rho >> 4, i = rho & 15; return 8 * (i >> 2) + 4 * n + (i & 3); }

struct Unit { int pm, pn, k0; };
struct Gemm { const bf16_t* A; const bf16_t* Bt; int M, N, K, ld; };

struct StaticOrder {
    int nM, nN, nwg, G, c;
    __host__ __device__ void init(int M, int N, int G_, int c_) { nM = M / BM; nN = N / BM; nwg = nM * nN; G = G_; c = c_; }
    __host__ __device__ bool next(int i, Unit& u) const {
        const long L = (long)i * G + c; if (L >= nwg) return false;
        int wgid = (int)L; { const int q = nwg / NXCD, r = nwg % NXCD, xcd = wgid % NXCD, off = wgid / NXCD; wgid = (xcd < r ? xcd * (q + 1) : r * (q + 1) + (xcd - r) * q) + off; }
        const int nig = WGM * nN, gid = wgid / nig, fm = gid * WGM, gsz = (nM - fm) < WGM ? (nM - fm) : WGM;
        u.pm = fm + ((wgid % nig) % gsz); u.pn = (wgid % nig) / gsz; u.k0 = 0; return true;
    }
    __device__ __forceinline__ void a_ready(const Unit&) const {}
    __device__ __forceinline__ void done(const Unit&) const {}
};

__device__ __forceinline__ unsigned cvt_pk_bf16(float lo, float hi) { unsigned r; asm volatile("v_cvt_pk_bf16_f32 %0, %1, %2" : "=v"(r) : "v"(lo), "v"(hi)); return r; }
__device__ __forceinline__ float fast_sigmoid(float x) { return __builtin_amdgcn_rcpf(1.0f + __builtin_amdgcn_exp2f(-1.4426950408889634f * x)); }

struct EpiF32B {
    static constexpr bool PERM = false, AFTER_DRAIN = false;
    float* C; int ldc; const float* bias;
    __device__ __forceinline__ void operator()(const f32x4 (&acc)[2][2][4][2], const Unit& u, int wr, int wc, int fr, int fq) const {
        const int row0 = u.pm * BM + wr * 64 + fr, col0 = u.pn * BM + wc * 32 + 4 * fq;
        f32x4 bv[2][2];
#pragma unroll
        for (int bj = 0; bj < 2; ++bj)
#pragma unroll
            for (int n = 0; n < 2; ++n) bv[bj][n] = *(const f32x4*)(bias + col0 + bj * HALF + n * 16);
#pragma unroll
        for (int ai = 0; ai < 2; ++ai)
#pragma unroll
            for (int m = 0; m < 4; ++m) { float* rowp = C + (size_t)(row0 + ai * HALF + m * 16) * ldc + col0;
#pragma unroll
                for (int bj = 0; bj < 2; ++bj)
#pragma unroll
                    for (int n = 0; n < 2; ++n) *(f32x4*)(rowp + bj * HALF + n * 16) = acc[ai][bj][m][n] + bv[bj][n]; }
    }
};
struct EpiBf16P {
    static constexpr bool PERM = true, AFTER_DRAIN = false;
    bf16_t* O; int ldc;
    __device__ __forceinline__ void operator()(const f32x4 (&acc)[2][2][4][2], const Unit& u, int wr, int wc, int fr, int fq) const {
        const int row0 = u.pm * BM + wr * 64 + fr, col0 = u.pn * BM + wc * 32 + 8 * fq;
#pragma unroll
        for (int ai = 0; ai < 2; ++ai)
#pragma unroll
            for (int m = 0; m < 4; ++m) { bf16_t* rowp = O + (size_t)(row0 + ai * HALF + m * 16) * ldc + col0;
#pragma unroll
                for (int bj = 0; bj < 2; ++bj) { const f32x4 v0 = acc[ai][bj][m][0], v1 = acc[ai][bj][m][1];
                    u32x4 w; w.x = cvt_pk_bf16(v0[0], v0[1]); w.y = cvt_pk_bf16(v0[2], v0[3]); w.z = cvt_pk_bf16(v1[0], v1[1]); w.w = cvt_pk_bf16(v1[2], v1[3]);
                    *(u32x4*)(rowp + bj * HALF) = w; } }
    }
};
struct EpiSwiglu {
    static constexpr bool PERM = true, AFTER_DRAIN = false;
    bf16_t* O; int ldc;
    __device__ __forceinline__ void operator()(const f32x4 (&acc)[2][2][4][2], const Unit& u, int wr, int wc, int fr, int fq) const {
        const int row0 = u.pm * BM + wr * 64 + fr, col0 = u.pn * HALF + wc * 32 + 8 * fq;
#pragma unroll
        for (int ai = 0; ai < 2; ++ai)
#pragma unroll
            for (int m = 0; m < 4; ++m) { bf16_t* rowp = O + (size_t)(row0 + ai * HALF + m * 16) * ldc + col0;
                float h[8];
#pragma unroll
                for (int n = 0; n < 2; ++n)
#pragma unroll
                    for (int i = 0; i < 4; ++i) { const float g = acc[ai][0][m][n][i], up = acc[ai][1][m][n][i]; h[n * 4 + i] = g * fast_sigmoid(g) * up; }
                u32x4 w; w.x = cvt_pk_bf16(h[0], h[1]); w.y = cvt_pk_bf16(h[2], h[3]); w.z = cvt_pk_bf16(h[4], h[5]); w.w = cvt_pk_bf16(h[6], h[7]);
                *(u32x4*)rowp = w; }
    }
};

struct EpiPartial {
    static constexpr bool PERM = false, AFTER_DRAIN = false;
    float* P; int KS, pm0;
    __device__ __forceinline__ void operator()(const f32x4 (&acc)[2][2][4][2], const Unit& u, int wr, int wc, int fr, int fq) const {
        float* C = P + (size_t)(u.k0 / KS) * (512 * 1024);
        const int row0 = (u.pm - pm0) * BM + wr * 64 + fr, col0 = u.pn * BM + wc * 32 + 4 * fq;
#pragma unroll
        for (int ai = 0; ai < 2; ++ai)
#pragma unroll
            for (int m = 0; m < 4; ++m) { float* rowp = C + (size_t)(row0 + ai * HALF + m * 16) * 1024 + col0;
#pragma unroll
                for (int bj = 0; bj < 2; ++bj)
#pragma unroll
                    for (int n = 0; n < 2; ++n) *(f32x4*)(rowp + bj * HALF + n * 16) = acc[ai][bj][m][n]; }
    }
};
struct SplitKOrder {
    int nN, nS, KS, G, c, pm0;
    __device__ bool next(int i, Unit& u) const {
        const int L = i * G + c; if (L >= 2 * nN * nS) return false;
        u.k0 = (L % nS) * KS; const int r = L / nS; u.pn = r % nN; u.pm = pm0 + r / nN; return true;
    }
    __device__ __forceinline__ void a_ready(const Unit&) const {}
    __device__ __forceinline__ void done(const Unit&) const {}
};

template <class Epi, class Sched, bool ALIGN_EPI = false, bool SP2 = false>
__device__ __forceinline__ void gemm_phase(PG8_LAS unsigned char* lds, const Gemm g, const Sched& S, const Epi& E) {
    int tid_ = threadIdx.x; asm volatile("" : "+v"(tid_)); const int tid = tid_, wid = __builtin_amdgcn_readfirstlane(tid >> 6), lane = tid & 63, wr = wid >> 2, wc = wid & 3, fr = lane & 15, fq = lane >> 4;
    const int K = g.K, nt = K / BK, LD = g.ld;
    unsigned voffA[2], voffB[2];
#pragma unroll
    for (int i = 0; i < 2; ++i) { int R, C; stage_rc(tid * 16 + i * 8192, R, C); const int Rb = Epi::PERM ? ((R & ~31) + perm32(R & 31)) : R;
        voffA[i] = (unsigned)(R * LD + C) * 2u; voffB[i] = (unsigned)(Rb * LD + C) * 2u; }
    const size_t kstep = (size_t)(BK * 2);
    const size_t hstep = (size_t)HALF * LD * 2;
    const size_t tstep = 2 * hstep;
    const unsigned ldsw = (unsigned)wid * 1024u;
    const int aoff = lds_byte(wr * 64 + fr, fq * 8), boff = lds_byte(wc * 32 + fr, fq * 8);
#define PG8_SA(b, h) (((b) * 2 + (h)) * HTB)
#define PG8_SB(b, h) ((4 + (b) * 2 + (h)) * HTB)
#define PG8_STAGE(bufoff, gbase, voff) do { _Pragma("unroll") for (int _i = 0; _i < 2; ++_i) \
        __builtin_amdgcn_global_load_lds((const unsigned*)((const char*)(gbase) + (voff)[_i]), (PG8_LAS unsigned*)(lds + (bufoff) + ldsw + _i * 8192), 16, 0, 0); } while (0)
#define PG8_LDA(dst, b, h) do { _Pragma("unroll") for (int m = 0; m < 4; ++m) _Pragma("unroll") for (int k = 0; k < 2; ++k) dst[m][k] = *(const PG8_LAS bf16x8*)(lds + PG8_SA(b, h) + aoff + m * 2048 + k * 1024); } while (0)
#define PG8_LDB(dst, b, h) do { _Pragma("unroll") for (int n = 0; n < 2; ++n) _Pragma("unroll") for (int k = 0; k < 2; ++k) dst[n][k] = *(const PG8_LAS bf16x8*)(lds + PG8_SB(b, h) + boff + n * 2048 + k * 1024); } while (0)
#define PG8_MMA(ai, bj, At, Bt) do { __builtin_amdgcn_s_setprio(1); _Pragma("unroll") for (int m = 0; m < 4; ++m) _Pragma("unroll") for (int n = 0; n < 2; ++n) _Pragma("unroll") for (int k = 0; k < 2; ++k) \
        acc[ai][bj][m][n] = __builtin_amdgcn_mfma_f32_16x16x32_bf16(Bt[n][k], At[m][k], acc[ai][bj][m][n], 0, 0, 0); __builtin_amdgcn_s_setprio(0); } while (0)
#define PG8_WAIT_V(n) asm volatile("s_waitcnt vmcnt(" #n ")" ::: "memory")
#define PG8_WAIT_L(n) asm volatile("s_waitcnt lgkmcnt(" #n ")" ::: "memory")
#define PG8_BAR __builtin_amdgcn_s_barrier()
#define PG8_SCHED __builtin_amdgcn_sched_barrier(0)
    Unit cur, nxt; int ui = 0;
    if (!S.next(0, cur)) return;
    f32x4 acc[2][2][4][2];
#pragma unroll
    for (int a = 0; a < 2; ++a)
#pragma unroll
        for (int b = 0; b < 2; ++b)
#pragma unroll
            for (int m = 0; m < 4; ++m)
#pragma unroll
                for (int n = 0; n < 2; ++n) acc[a][b][m][n] = (f32x4){0.f, 0.f, 0.f, 0.f};
    bf16x8 At[4][2], B0[2][2], B1[2][2];
    const char* cA = (const char*)g.A + (size_t)cur.pm * tstep + (size_t)cur.k0 * 2; const char* cB = (const char*)g.Bt + (size_t)cur.pn * tstep + (size_t)cur.k0 * 2;
    S.a_ready(cur);
    if constexpr (SP2) {
        PG8_STAGE(PG8_SB(0, 0), cB, voffB); PG8_STAGE(PG8_SB(0, 1), cB + hstep, voffB); PG8_STAGE(PG8_SA(0, 0), cA, voffA); PG8_STAGE(PG8_SA(0, 1), cA + hstep, voffA);
        if (wr == 1) PG8_BAR;
        PG8_WAIT_V(2); PG8_BAR;
        PG8_STAGE(PG8_SB(1, 0), cB + kstep, voffB); PG8_STAGE(PG8_SA(1, 0), cA + kstep, voffA); PG8_STAGE(PG8_SB(1, 1), cB + hstep + kstep, voffB);
        PG8_WAIT_V(6); PG8_BAR;
    } else {
        PG8_STAGE(PG8_SB(0, 0), cB, voffB); PG8_STAGE(PG8_SA(0, 0), cA, voffA); PG8_STAGE(PG8_SB(0, 1), cB + hstep, voffB); PG8_STAGE(PG8_SA(0, 1), cA + hstep, voffA);
        if (wr == 1) PG8_BAR;
        PG8_WAIT_V(4); PG8_BAR;
        PG8_STAGE(PG8_SB(1, 0), cB + kstep, voffB); PG8_STAGE(PG8_SA(1, 0), cA + kstep, voffA); PG8_STAGE(PG8_SB(1, 1), cB + hstep + kstep, voffB);
        PG8_WAIT_V(6); PG8_BAR;
    }
    for (;;) {
        const bool has_next = S.next(ui + 1, nxt);
        const char* nA = has_next ? (const char*)g.A + (size_t)nxt.pm * tstep + (size_t)nxt.k0 * 2 : cA; const char* nB = has_next ? (const char*)g.Bt + (size_t)nxt.pn * tstep + (size_t)nxt.k0 * 2 : cB;
        for (int t = 0; t < nt; t += 2) {
            const bool last = (t == nt - 2);
            const char* a1 = cA + (size_t)(t + 1) * kstep;
            const char* a2 = last ? nA : cA + (size_t)(t + 2) * kstep; const char* b2 = last ? nB : cB + (size_t)(t + 2) * kstep;
            const char* a3 = a2 + kstep; const char* b3 = b2 + kstep;
            if (last && has_next) S.a_ready(nxt);
            if constexpr (SP2) {
            PG8_LDB(B0, 0, 0); PG8_LDB(B1, 0, 1); PG8_SCHED; PG8_LDA(At, 0, 0); PG8_STAGE(PG8_SA(1, 1), a1 + hstep, voffA);
            PG8_WAIT_V(8); PG8_WAIT_L(0); PG8_BAR; PG8_MMA(0, 0, At, B0); PG8_MMA(0, 1, At, B1); PG8_BAR; PG8_SCHED;
            PG8_LDA(At, 0, 1); PG8_STAGE(PG8_SB(0, 0), b2, voffB); PG8_STAGE(PG8_SB(0, 1), b2 + hstep, voffB); PG8_STAGE(PG8_SA(0, 0), a2, voffA);
            PG8_WAIT_V(8); PG8_WAIT_L(0); PG8_BAR; PG8_MMA(1, 0, At, B0); PG8_MMA(1, 1, At, B1); PG8_BAR; PG8_SCHED;
            PG8_LDB(B0, 1, 0); PG8_LDB(B1, 1, 1); PG8_SCHED; PG8_LDA(At, 1, 0); PG8_STAGE(PG8_SA(0, 1), a2 + hstep, voffA);
            PG8_WAIT_V(8); PG8_WAIT_L(0); PG8_BAR; PG8_MMA(0, 0, At, B0); PG8_MMA(0, 1, At, B1); PG8_BAR; PG8_SCHED;
            PG8_LDA(At, 1, 1); PG8_STAGE(PG8_SB(1, 0), b3, voffB); PG8_STAGE(PG8_SB(1, 1), b3 + hstep, voffB); PG8_STAGE(PG8_SA(1, 0), a3, voffA);
            PG8_WAIT_V(8); PG8_WAIT_L(0); PG8_BAR; PG8_MMA(1, 0, At, B0); PG8_MMA(1, 1, At, B1); PG8_BAR; PG8_SCHED;
            } else {
            PG8_LDB(B0, 0, 0); PG8_SCHED; PG8_LDA(At, 0, 0); PG8_STAGE(PG8_SA(1, 1), a1 + hstep, voffA);
            PG8_WAIT_L(8); PG8_BAR; PG8_WAIT_L(0); PG8_MMA(0, 0, At, B0); PG8_BAR; PG8_SCHED;
            PG8_LDB(B1, 0, 1); PG8_STAGE(PG8_SB(0, 0), b2, voffB);
            PG8_BAR; PG8_WAIT_L(0); PG8_MMA(0, 1, At, B1); PG8_BAR;
            PG8_LDA(At, 0, 1); PG8_STAGE(PG8_SA(0, 0), a2, voffA);
            PG8_BAR; PG8_WAIT_L(0); PG8_MMA(1, 0, At, B0); PG8_BAR; PG8_SCHED;
            PG8_STAGE(PG8_SB(0, 1), b2 + hstep, voffB);
            PG8_WAIT_V(6); PG8_BAR; PG8_MMA(1, 1, At, B1); PG8_BAR;
            PG8_LDB(B0, 1, 0); PG8_SCHED; PG8_LDA(At, 1, 0); PG8_STAGE(PG8_SA(0, 1), a2 + hstep, voffA);
            PG8_WAIT_L(8); PG8_BAR; PG8_WAIT_L(0); PG8_MMA(0, 0, At, B0); PG8_BAR; PG8_SCHED;
            PG8_LDB(B1, 1, 1); PG8_STAGE(PG8_SB(1, 0), b3, voffB);
            PG8_BAR; PG8_WAIT_L(0); PG8_MMA(0, 1, At, B1); PG8_BAR;
            PG8_LDA(At, 1, 1); PG8_STAGE(PG8_SA(1, 0), a3, voffA);
            PG8_BAR; PG8_WAIT_L(0); PG8_MMA(1, 0, At, B0); PG8_BAR; PG8_SCHED;
            PG8_STAGE(PG8_SB(1, 1), b3 + hstep, voffB);
            PG8_WAIT_V(6); PG8_BAR; PG8_MMA(1, 1, At, B1); PG8_BAR;
            }
        }
        if constexpr (ALIGN_EPI) { if (wr == 0) PG8_BAR; }
        if constexpr (!Epi::AFTER_DRAIN) { E(acc, cur, wr, wc, fr, fq); S.done(cur); }
        if (!has_next) break;
#pragma unroll
        for (int a = 0; a < 2; ++a)
#pragma unroll
            for (int b = 0; b < 2; ++b)
#pragma unroll
                for (int m = 0; m < 4; ++m)
#pragma unroll
                    for (int n = 0; n < 2; ++n) acc[a][b][m][n] = (f32x4){0.f, 0.f, 0.f, 0.f};
        cur = nxt; cA = nA; cB = nB; ++ui;
        if constexpr (ALIGN_EPI) { if (wr == 1) PG8_BAR; }
    }
    PG8_WAIT_V(0);
    if constexpr (!ALIGN_EPI) { if (wr == 0) PG8_BAR; }
    PG8_BAR;
    if constexpr (Epi::AFTER_DRAIN) { E.fused(acc, cur, wr, wc, fr, fq, lds, wid, lane); S.done(cur); }
#undef PG8_SA
#undef PG8_SB
#undef PG8_STAGE
#undef PG8_LDA
#undef PG8_LDB
#undef PG8_MMA
#undef PG8_WAIT_V
#undef PG8_WAIT_L
#undef PG8_BAR
#undef PG8_SCHED
}
}

#define LAS __attribute__((address_space(3)))
typedef unsigned short bf16_t;
typedef float f32x4 __attribute__((ext_vector_type(4)));
typedef unsigned u32x4 __attribute__((ext_vector_type(4)));
typedef unsigned u32x2 __attribute__((ext_vector_type(2)));
constexpr int DM = 1024, NPT = 16384, NST = 512, MT = NPT + NST, TSEQ = 2048;
constexpr int DFF = 2816, NUP = 5632, DIN = 2816, NSH = 1792, DRW = 512, DCV = 512, CWID = 31, NLR = 1536, KLR = 256, NADA = 9216;
constexpr float RMS_EPS = 1e-6f, LN_EPS = 1e-5f, GN_EPS = 64e-5f, LOG2E = 1.4426950408889634f;
constexpr size_t O_Y = 0, O_WKVP = 17301504, O_SHP = 17563648, O_CVP = 17577984, O_WKVS = 17700864, O_SHS = 21895168, O_CVS = 22124544, O_END = 24090624;
constexpr size_t MiB = 1u << 20;
constexpr size_t WS_ADA = 0;
constexpr size_t WS_SC = 9437184;
constexpr size_t WS_WADA = 10 * MiB;
constexpr size_t WS_PART = 10 * MiB;
constexpr size_t WS_WUP1 = 28 * MiB;
constexpr size_t WS_WDN1 = 39 * MiB;
constexpr size_t WS_WIN = WS_WDN1 + 5767168;
constexpr size_t WS_WLR = 50 * MiB;
constexpr size_t WS_WOUT = 51 * MiB;
constexpr size_t WS_WUP2 = 53 * MiB;
constexpr size_t WS_WDN2 = 64 * MiB;
constexpr size_t WS_L = 70 * MiB;
constexpr size_t WS_H = 79 * MiB;
constexpr size_t WS_D = 112 * MiB;
constexpr size_t WS_ACT = 162 * MiB;
constexpr size_t WS_END = WS_ACT + (size_t)MT * DFF * 2;
constexpr size_t WS_CTL = 253 * MiB, CTL_BYTES = 16384;
static_assert(WS_END <= WS_CTL && WS_CTL + CTL_BYTES <= 256 * MiB, "ws map");
constexpr int LDS_CTL_OFF = 131072;
constexpr int LDS_BYTES = 147456;

struct KArgs { const float* in[32]; float* out; unsigned char* ws; };
typedef const __attribute__((address_space(4))) KArgs* KP;

__device__ __forceinline__ float bf_lo(unsigned u) { return __builtin_bit_cast(float, u << 16); }
__device__ __forceinline__ float bf_hi(unsigned u) { return __builtin_bit_cast(float, u & 0xffff0000u); }
__device__ __forceinline__ float bf1(bf16_t b) { return __builtin_bit_cast(float, ((unsigned)b) << 16); }
__device__ __forceinline__ unsigned pk2(float lo, float hi) { return pg8::cvt_pk_bf16(lo, hi); }
__device__ __forceinline__ float sigm(float x) { return pg8::fast_sigmoid(x); }
__device__ __forceinline__ float tanh_fast(float x) { const float e = __builtin_amdgcn_exp2f(2.0f * LOG2E * x); return 1.0f - 2.0f * __builtin_amdgcn_rcpf(e + 1.0f); }
__device__ __forceinline__ float rsq(float x) { return 1.0f / sqrtf(x); }
__device__ __forceinline__ void ld8bf(const bf16_t* p, float (&o)[8]) { const u32x4 r = *(const u32x4*)p;
    o[0] = bf_lo(r.x); o[1] = bf_hi(r.x); o[2] = bf_lo(r.y); o[3] = bf_hi(r.y); o[4] = bf_lo(r.z); o[5] = bf_hi(r.z); o[6] = bf_lo(r.w); o[7] = bf_hi(r.w); }
__device__ __forceinline__ void ld8f(const float* p, float (&o)[8]) { const f32x4 a = *(const f32x4*)p, b = *(const f32x4*)(p + 4);
    o[0] = a.x; o[1] = a.y; o[2] = a.z; o[3] = a.w; o[4] = b.x; o[5] = b.y; o[6] = b.z; o[7] = b.w; }
__device__ __forceinline__ f32x4 ld4bf(const bf16_t* p) { const u32x2 r = *(const u32x2*)p; return (f32x4){bf_lo(r.x), bf_hi(r.x), bf_lo(r.y), bf_hi(r.y)}; }
__device__ __forceinline__ float wave_sum(float v) {
#pragma unroll
    for (int o = 1; o < 64; o <<= 1) v += __shfl_xor(v, o);
    return v;
}
template <int CTRL> __device__ __forceinline__ float dpp_mov(float x) { return __builtin_bit_cast(float, __builtin_amdgcn_update_dpp(0, __builtin_bit_cast(int, x), CTRL, 0xF, 0xF, true)); }
__device__ __forceinline__ float red8(float x) { x += dpp_mov<0xB1>(x); x += dpp_mov<0x4E>(x); x += dpp_mov<0x141>(x); return x; }
__device__ __forceinline__ float red16(float x) { x = red8(x); x += dpp_mov<0x140>(x); return x; }
__device__ __forceinline__ int batch_of_row(int m) { return m < NPT ? (m >> 11) : 8 + ((m - NPT) >> 2); }
#define LDS_WAIT() asm volatile("s_waitcnt lgkmcnt(0)" ::: "memory")
#define LBAR() do { asm volatile("s_waitcnt lgkmcnt(0)" ::: "memory"); __builtin_amdgcn_s_barrier(); asm volatile("" ::: "memory"); } while (0)

__device__ __forceinline__ void p0_transpose_item(const float* W, int K, int N, bf16_t* WT, int swi, LAS float* scr, int item, int lane) {
    const int nblk = N / 32, kb = item / nblk, nb = item % nblk, k0 = 64 * kb, n0 = 32 * nb;
    int s0 = n0;
    if (swi) { const int pn = n0 >> 8, bj = (n0 >> 7) & 1, j0 = n0 & 127; s0 = bj * DFF + 128 * pn + j0; }
#pragma unroll 8
    for (int i = 0; i < 32; ++i) { const int kk = 2 * i + (lane >> 5); scr[kk * 33 + (lane & 31)] = W[(size_t)(k0 + kk) * N + s0 + (lane & 31)]; }
    LDS_WAIT(); asm volatile("" ::: "memory");
    const int c = lane & 7;
#pragma unroll
    for (int j = 0; j < 4; ++j) { const int n = (lane >> 3) + 8 * j; const LAS float* s = scr + (8 * c) * 33 + n;
        u32x4 o; o.x = pk2(s[0 * 33], s[1 * 33]); o.y = pk2(s[2 * 33], s[3 * 33]); o.z = pk2(s[4 * 33], s[5 * 33]); o.w = pk2(s[6 * 33], s[7 * 33]);
        *(u32x4*)(WT + (size_t)(n0 + n) * K + k0 + 8 * c) = o; }
    LDS_WAIT(); asm volatile("" ::: "memory");
}
__device__ __forceinline__ void p0_prologue(KP A, LAS unsigned char* lds, int tid, int wave, int lane) {
    LAS float* scr = (LAS float*)(lds + wave * 16384);
    const int gw = blockIdx.x * 8 + wave, NGW = gridDim.x * 8;
    unsigned char* ws = A->ws;
    constexpr int I_ADA = 16 * (NADA / 32), I_UP = 16 * (NUP / 32), I_DN = (DFF / 64) * (DM / 32), I_IN = 16 * (DIN / 32), I_OUT = 16 * (DM / 32);
    constexpr int NITEMS = I_ADA + 2 * I_UP + 2 * I_DN + I_IN + I_OUT;
    for (int it = gw; it < NITEMS; it += NGW) {
        int r = it;
        if (r < I_ADA) { p0_transpose_item(A->in[7], DM, NADA, (bf16_t*)(ws + WS_WADA), 0, scr, r, lane); continue; } r -= I_ADA;
        if (r < I_UP) { p0_transpose_item(A->in[11], DM, NUP, (bf16_t*)(ws + WS_WUP1), 1, scr, r, lane); continue; } r -= I_UP;
        if (r < I_UP) { p0_transpose_item(A->in[30], DM, NUP, (bf16_t*)(ws + WS_WUP2), 1, scr, r, lane); continue; } r -= I_UP;
        if (r < I_DN) { p0_transpose_item(A->in[12], DFF, DM, (bf16_t*)(ws + WS_WDN1), 0, scr, r, lane); continue; } r -= I_DN;
        if (r < I_DN) { p0_transpose_item(A->in[31], DFF, DM, (bf16_t*)(ws + WS_WDN2), 0, scr, r, lane); continue; } r -= I_DN;
        if (r < I_IN) { p0_transpose_item(A->in[13], DM, DIN, (bf16_t*)(ws + WS_WIN), 0, scr, r, lane); continue; } r -= I_IN;
        p0_transpose_item(A->in[29], DM, DM, (bf16_t*)(ws + WS_WOUT), 0, scr, r, lane);
    }
    const int gt = blockIdx.x * 512 + tid, NGT = gridDim.x * 512;
    bf16_t* wlr = (bf16_t*)(ws + WS_WLR);
    for (int i = gt; i < NLR * KLR; i += NGT) {
        const int n = i >> 8, k = i & 255; float v = 0.f;
        if (n < 512) { if (k < 64) v = A->in[16][k * 512 + n]; }
        else if (n < 1024) { if (k >= 64 && k < 128) v = A->in[18][(k - 64) * 512 + (n - 512)]; }
        else { if (k >= 128) v = A->in[19][(k - 128) * 512 + (n - 1024)]; }
        wlr[i] = (bf16_t)(pk2(v, 0.f) & 0xffffu);
    }
    bf16_t* sc = (bf16_t*)(ws + WS_SC);
    for (int i = gt; i < 256 * DM; i += NGT) {
        const int b = i >> 10, c = i & 1023; float v = 0.f;
        if (b < 8) v = A->in[2][b * DM + c]; else if (b < 136) v = A->in[3][(b - 8) * DM + c];
        v = v * sigm(v);
        sc[i] = (bf16_t)(pk2(v, 0.f) & 0xffffu);
    }
}

template <int MODE>
__device__ __forceinline__ void row_pass(KP A, int wave, int lane, int sub_prev, float res_w, int sub_next, int nsplit) {
    const int gw = blockIdx.x * 8 + wave, NGW = gridDim.x * 8;
    const float* ada = (const float*)(A->ws + WS_ADA);
    const bf16_t* D = (const bf16_t*)(A->ws + WS_D);
    bf16_t* H = (bf16_t*)(A->ws + WS_H);
    const float* gpre = A->in[9] + sub_next * DM; const float* gpost = A->in[10] + sub_prev * DM;
    for (int m = gw; m < MT; m += NGW) {
        const float* adab = ada + (size_t)batch_of_row(m) * NADA;
        float* xo = A->out + (size_t)m * DM;
        const float* xi = (MODE == 0 || sub_prev == 0) ? (m < NPT ? A->in[0] + (size_t)m * DM : A->in[1] + (size_t)(m - NPT) * DM) : xo;
        f32x4 v[4];
#pragma unroll
        for (int j = 0; j < 4; ++j) v[j] = *(const f32x4*)(xi + 4 * lane + 256 * j);
        if (MODE >= 1) {
            f32x4 d[4]; float ss = 0.f;
#pragma unroll
            for (int j = 0; j < 4; ++j) {
                if (m < NPT) d[j] = ld4bf(D + (size_t)m * DM + 4 * lane + 256 * j);
                else { const float* pp = (const float*)(A->ws + WS_PART) + (size_t)(m - NPT) * DM + 4 * lane + 256 * j; d[j] = *(const f32x4*)pp;
                    for (int sp = 1; sp < nsplit; ++sp) d[j] += *(const f32x4*)(pp + (size_t)sp * (512 * 1024)); }
                ss += (d[j].x * d[j].x + d[j].y * d[j].y) + (d[j].z * d[j].z + d[j].w * d[j].w); }
            const float rs = rsq(wave_sum(ss) * (1.0f / DM) + RMS_EPS);
#pragma unroll
            for (int j = 0; j < 4; ++j) { const int col = 4 * lane + 256 * j;
                const f32x4 g = *(const f32x4*)(gpost + col), gt = *(const f32x4*)(adab + (sub_prev * 3 + 2) * DM + col);
                v[j] = v[j] + (res_w * gt) * ((d[j] * rs) * g);
                *(f32x4*)(xo + col) = v[j]; }
        }
        if (MODE <= 1) {
            float ss = 0.f;
#pragma unroll
            for (int j = 0; j < 4; ++j) ss += (v[j].x * v[j].x + v[j].y * v[j].y) + (v[j].z * v[j].z + v[j].w * v[j].w);
            const float rs = rsq(wave_sum(ss) * (1.0f / DM) + RMS_EPS);
#pragma unroll
            for (int j = 0; j < 4; ++j) { const int col = 4 * lane + 256 * j;
                const f32x4 g = *(const f32x4*)(gpre + col), sc = *(const f32x4*)(adab + (sub_next * 3 + 1) * DM + col), sh = *(const f32x4*)(adab + (sub_next * 3 + 0) * DM + col);
                const f32x4 h = ((v[j] * rs) * g) * (1.0f + sc) + sh;
                u32x2 w; w.x = pk2(h.x, h.y); w.y = pk2(h.z, h.w);
                *(u32x2*)(H + (size_t)m * DM + col) = w; }
        }
    }
}

__device__ __forceinline__ void p7_lowrank_inputs(KP A, int wave, int lane) {
    const int gw = blockIdx.x * 8 + wave, NGW = gridDim.x * 8;
    const bf16_t* PROJ = (const bf16_t*)(A->ws + WS_ACT);
    bf16_t* L = (bf16_t*)(A->ws + WS_L);
    const float* mu = A->in[14];
    for (int m = gw; m < MT; m += NGW) {
        bool first, last; const float* st = nullptr; float* sho;
        if (m < NPT) { const int t = m & 2047; first = (t == 0); last = (t == 2047); sho = A->out + O_SHP + (size_t)(m >> 11) * NSH; }
        else { const int ms = m - NPT, seq = ms >> 2, t = ms & 3; first = (t == 0); last = (t == 3); st = A->in[5] + (size_t)seq * NSH; sho = A->out + O_SHS + (size_t)seq * NSH; }
        const int col = 1536 + 4 * lane;
        const f32x4 p = ld4bf(PROJ + (size_t)m * DIN + col);
        f32x4 pv = (f32x4){0.f, 0.f, 0.f, 0.f};
        if (!first) pv = ld4bf(PROJ + (size_t)(m - 1) * DIN + col); else if (st) pv = *(const f32x4*)(st + col);
        const f32x4 mm = *(const f32x4*)(mu + col);
        const f32x4 xs = p + (pv - p) * mm;
        f32x4 o;
        if (lane < 16) o = (f32x4){tanh_fast(xs.x), tanh_fast(xs.y), tanh_fast(xs.z), tanh_fast(xs.w)};
        else if (lane < 32) o = xs;
        else o = (f32x4){sigm(xs.x), sigm(xs.y), sigm(xs.z), sigm(xs.w)};
        u32x2 w; w.x = pk2(o.x, o.y); w.y = pk2(o.z, o.w);
        *(u32x2*)(L + (size_t)m * KLR + 4 * lane) = w;
        if (last) { for (int cc = 4 * lane; cc < NSH; cc += 256) *(f32x4*)(sho + cc) = ld4bf(PROJ + (size_t)m * DIN + cc); }
    }
}
__device__ __forceinline__ void conv_ln_store(KP A, LAS float* Z, int m0, int wave, int lane) {
    bf16_t* YZ = (bf16_t*)(A->ws + WS_H);
    float g[8], bb[8]; ld8f(A->in[27] + 8 * lane, g); ld8f(A->in[28] + 8 * lane, bb);
#pragma unroll
    for (int q = 0; q < 4; ++q) { const int tt = 4 * wave + q;
        const f32x4 a = *(const LAS f32x4*)(Z + tt * 512 + 8 * lane), b = *(const LAS f32x4*)(Z + tt * 512 + 8 * lane + 4);
        float z[8] = {a.x, a.y, a.z, a.w, b.x, b.y, b.z, b.w};
        float s = 0.f;
#pragma unroll
        for (int e = 0; e < 8; ++e) s += z[e];
        const float mean = wave_sum(s) * (1.0f / 512.0f); float qv = 0.f;
#pragma unroll
        for (int e = 0; e < 8; ++e) { z[e] -= mean; qv += z[e] * z[e]; }
        const float rs = rsq(wave_sum(qv) * (1.0f / 512.0f) + LN_EPS);
        float o[8];
#pragma unroll
        for (int e = 0; e < 8; ++e) { const float y = z[e] * rs * g[e] + bb[e]; o[e] = y * sigm(y); }
        u32x4 w; w.x = pk2(o[0], o[1]); w.y = pk2(o[2], o[3]); w.z = pk2(o[4], o[5]); w.w = pk2(o[6], o[7]);
        *(u32x4*)(YZ + (size_t)(m0 + tt) * DM + 512 + 8 * lane) = w; }
}
__device__ __forceinline__ void p7_conv(KP A, LAS unsigned char* lds, int tid, int wave, int lane) {
    const bf16_t* PROJ = (const bf16_t*)(A->ws + WS_ACT);
    LAS float* Z = (LAS float*)lds;
    const int c = tid;
    float w[CWID];
#pragma unroll
    for (int j = 0; j < CWID; ++j) w[j] = A->in[25][j * DCV + c];
    const float cb = A->in[26][c];
    for (int tile = blockIdx.x; tile < 512 + 16; tile += gridDim.x) {
        if (tile < 512) {
            const int b = tile >> 6, t0 = (tile & 63) * 32;
            const bf16_t* P = PROJ + (size_t)(b * TSEQ) * DIN + NSH + c;
            float u[62];
#pragma unroll
            for (int i = 0; i < 62; ++i) { const int t = t0 - 30 + i;
                if (t >= 0) { const float ua = bf1(P[(size_t)t * DIN]), ug = bf1(P[(size_t)t * DIN + DCV]); u[i] = ua * sigm(ug); } else u[i] = 0.f; }
#pragma unroll
            for (int t = 0; t < 32; ++t) { float acc = cb;
#pragma unroll
                for (int j = 0; j < CWID; ++j) acc += w[j] * u[t + j];
                Z[t * 512 + c] = acc; }
            if (t0 == TSEQ - 32) {
#pragma unroll
                for (int i = 0; i < 30; ++i) A->out[O_CVP + (size_t)(b * 30 + i) * DCV + c] = u[32 + i]; }
            __syncthreads();
            conv_ln_store(A, Z, b * TSEQ + t0, wave, lane);
            __syncthreads();
        } else {
            const int s0 = (tile - 512) * 8;
            for (int si = 0; si < 8; ++si) { const int seq = s0 + si;
                float f[34];
#pragma unroll
                for (int i = 0; i < 30; ++i) f[i] = A->in[6][(size_t)(seq * 30 + i) * DCV + c];
                const bf16_t* P = PROJ + (size_t)(NPT + seq * 4) * DIN + NSH + c;
#pragma unroll
                for (int t = 0; t < 4; ++t) { const float ua = bf1(P[(size_t)t * DIN]), ug = bf1(P[(size_t)t * DIN + DCV]); f[30 + t] = ua * sigm(ug); }
#pragma unroll
                for (int t = 0; t < 4; ++t) { float acc = cb;
#pragma unroll
                    for (int j = 0; j < CWID; ++j) acc += w[j] * f[t + j];
                    Z[(si * 4 + t) * 512 + c] = acc; }
#pragma unroll
                for (int i = 0; i < 30; ++i) A->out[O_CVS + (size_t)(seq * 30 + i) * DCV + c] = f[i + 4];
            }
            __syncthreads();
            conv_ln_store(A, Z, NPT + s0 * 4, wave, lane);
            __syncthreads();
        }
    }
}

constexpr int SLOTB = 1280, OP_A = 0, OP_W = 256, OP_B = 512, OP_K = 768, OP_R = 1024, SC_V = 81920, SC_Y = 86016;
struct Slot { int m, seq, h, q; bool first, sample; };
__device__ __forceinline__ Slot slot_prompt(int item, int chunk, int s) { Slot x; x.seq = item >> 5; x.h = (item >> 2) & 7; x.q = item & 3; const int t = chunk * 64 + s; x.m = x.seq * TSEQ + t; x.first = (t == 0); x.sample = false; return x; }
__device__ __forceinline__ Slot slot_sample(int group, int s) { Slot x; const int i = group * 16 + (s >> 2), t = s & 3; x.seq = i >> 5; x.h = (i >> 2) & 7; x.q = i & 3; x.m = NPT + x.seq * 4 + t; x.first = (t == 0); x.sample = true; return x; }

__device__ __forceinline__ void lerp8(const bf16_t* PROJ, const float* st, const float* mu, const Slot& x, int col, float (&o)[8]) {
    float p[8], pv[8], mm[8];
    ld8bf(PROJ + (size_t)x.m * DIN + col, p);
    if (!x.first) ld8bf(PROJ + (size_t)(x.m - 1) * DIN + col, pv);
    else if (x.sample) ld8f(st + (size_t)x.seq * NSH + col, pv);
    else {
#pragma unroll
        for (int e = 0; e < 8; ++e) pv[e] = 0.f; }
    ld8f(mu + col, mm);
#pragma unroll
    for (int e = 0; e < 8; ++e) o[e] = p[e] + (pv[e] - p[e]) * mm[e];
}
__device__ __forceinline__ float rwkv_prep8(KP A, const Slot& x, int cg, float (&r)[8], float (&w)[8], float (&km)[8], float (&v)[8], float (&a)[8], float (&b)[8]) {
    const bf16_t* PROJ = (const bf16_t*)(A->ws + WS_ACT); const bf16_t* LR = (const bf16_t*)(A->ws + WS_D);
    const int gc = x.h * 64 + 8 * cg;
    float k[8];
    lerp8(PROJ, A->in[5], A->in[14], x, gc, r); lerp8(PROJ, A->in[5], A->in[14], x, 512 + gc, k); lerp8(PROJ, A->in[5], A->in[14], x, 1024 + gc, v);
    float dp[8], ip[8], w0[8], a0[8], kk_[8], ka[8], rk[8];
    ld8bf(LR + (size_t)x.m * NLR + gc, dp); ld8bf(LR + (size_t)x.m * NLR + 512 + gc, ip);
    ld8f(A->in[15] + gc, w0); ld8f(A->in[17] + gc, a0); ld8f(A->in[20] + gc, kk_); ld8f(A->in[21] + gc, ka); ld8f(A->in[22] + gc, rk);
    float ss = 0.f, bon = 0.f, ic[8], kv[8];
#pragma unroll
    for (int e = 0; e < 8; ++e) {
        const float sg = sigm(w0[e] + dp[e]);
        w[e] = __builtin_amdgcn_exp2f(-0.6065306597126334f * LOG2E * sg);
        ic[e] = sigm(a0[e] + ip[e]);
        kv[e] = k[e] * kk_[e]; ss += kv[e] * kv[e];
        km[e] = k[e] * (1.0f + (ic[e] - 1.0f) * ka[e]);
        bon += r[e] * km[e] * rk[e];
    }
    ss = red8(ss);
    const float inv = 1.0f / fmaxf(sqrtf(ss), 1e-12f);
#pragma unroll
    for (int e = 0; e < 8; ++e) { const float kn = kv[e] * inv; a[e] = -kn; b[e] = kn * ic[e]; }
    return bon;
}
__device__ __forceinline__ void scan_prep_store(KP A, LAS unsigned char* lds, const Slot& x, int s, int cg) {
    float r[8], w[8], km[8], v[8], a[8], b[8];
    (void)rwkv_prep8(A, x, cg, r, w, km, v, a, b);
    const int o = s * SLOTB + 32 * cg;
    *(LAS f32x4*)(lds + OP_R + o) = (f32x4){r[0], r[1], r[2], r[3]}; *(LAS f32x4*)(lds + OP_R + o + 16) = (f32x4){r[4], r[5], r[6], r[7]};
    *(LAS f32x4*)(lds + OP_W + o) = (f32x4){w[0], w[1], w[2], w[3]}; *(LAS f32x4*)(lds + OP_W + o + 16) = (f32x4){w[4], w[5], w[6], w[7]};
    *(LAS f32x4*)(lds + OP_K + o) = (f32x4){km[0], km[1], km[2], km[3]}; *(LAS f32x4*)(lds + OP_K + o + 16) = (f32x4){km[4], km[5], km[6], km[7]};
    *(LAS f32x4*)(lds + OP_A + o) = (f32x4){a[0], a[1], a[2], a[3]}; *(LAS f32x4*)(lds + OP_A + o + 16) = (f32x4){a[4], a[5], a[6], a[7]};
    *(LAS f32x4*)(lds + OP_B + o) = (f32x4){b[0], b[1], b[2], b[3]}; *(LAS f32x4*)(lds + OP_B + o + 16) = (f32x4){b[4], b[5], b[6], b[7]};
    if ((cg >> 1) == x.q) { const int ov = (s * 16 + (cg & 1) * 8) * 4;
        *(LAS f32x4*)(lds + SC_V + ov) = (f32x4){v[0], v[1], v[2], v[3]}; *(LAS f32x4*)(lds + SC_V + ov + 16) = (f32x4){v[4], v[5], v[6], v[7]}; }
}
__device__ __forceinline__ void scan_step(LAS unsigned char* lds, int s, int row16, int kq, f32x4& S) {
    const int o = s * SLOTB + 16 * kq;
    const f32x4 a = *(const LAS f32x4*)(lds + OP_A + o), w = *(const LAS f32x4*)(lds + OP_W + o), b = *(const LAS f32x4*)(lds + OP_B + o),
                k = *(const LAS f32x4*)(lds + OP_K + o), r = *(const LAS f32x4*)(lds + OP_R + o);
    const float vv = *(const LAS float*)(lds + SC_V + (s * 16 + row16) * 4);
    float sa = (S.x * a.x + S.y * a.y) + (S.z * a.z + S.w * a.w);
    const f32x4 pre = S * w + vv * k;
    sa = red16(sa);
    S = pre + sa * b;
    float y = (S.x * r.x + S.y * r.y) + (S.z * r.z + S.w * r.w);
    y = red16(y);
    if (kq == 0) *(LAS float*)(lds + SC_Y + (s * 16 + row16) * 4) = y;
}
__device__ __forceinline__ void scan_store_y(KP A, LAS unsigned char* lds, const Slot& x, int s, int pr) {
    bf16_t* YZ = (bf16_t*)(A->ws + WS_H);
    const float y0 = *(const LAS float*)(lds + SC_Y + (s * 16 + 2 * pr) * 4), y1 = *(const LAS float*)(lds + SC_Y + (s * 16 + 2 * pr + 1) * 4);
    *(unsigned*)(YZ + (size_t)x.m * DM + x.h * 64 + x.q * 16 + 2 * pr) = pk2(y0, y1);
}

struct Raw { u32x4 pr, pk, pv, qr, qk, qv, dp, ip; };
struct Par { float mr[8], mk[8], mv[8], w0[8], a0[8], kk[8], ka[8]; };
__device__ __forceinline__ void raw_load(KP A, int m, bool first, int gc, Raw& R) {
    const bf16_t* P = (const bf16_t*)(A->ws + WS_ACT) + (size_t)m * DIN + gc;
    R.pr = *(const u32x4*)P; R.pk = *(const u32x4*)(P + 512); R.pv = *(const u32x4*)(P + 1024);
    if (!first) { const bf16_t* Q = P - DIN; R.qr = *(const u32x4*)Q; R.qk = *(const u32x4*)(Q + 512); R.qv = *(const u32x4*)(Q + 1024); }
    else { R.qr = (u32x4){0u, 0u, 0u, 0u}; R.qk = R.qr; R.qv = R.qr; }
    const bf16_t* Lp = (const bf16_t*)(A->ws + WS_D) + (size_t)m * NLR + gc;
    R.dp = *(const u32x4*)Lp; R.ip = *(const u32x4*)(Lp + 512);
}
__device__ __forceinline__ void unpk8(const u32x4 r, float (&o)[8]) { o[0] = bf_lo(r.x); o[1] = bf_hi(r.x); o[2] = bf_lo(r.y); o[3] = bf_hi(r.y); o[4] = bf_lo(r.z); o[5] = bf_hi(r.z); o[6] = bf_lo(r.w); o[7] = bf_hi(r.w); }
__device__ __forceinline__ void prep_store_raw(LAS unsigned char* lds, const Raw& R, const Par& P, int s, int cg, int q) {
    float p[8], pv[8], r[8], k[8], v[8], dp[8], ip[8], w[8], km[8], a[8], b[8], ic[8], kv[8];
    unpk8(R.pr, p); unpk8(R.qr, pv);
#pragma unroll
    for (int e = 0; e < 8; ++e) r[e] = p[e] + (pv[e] - p[e]) * P.mr[e];
    unpk8(R.pk, p); unpk8(R.qk, pv);
#pragma unroll
    for (int e = 0; e < 8; ++e) k[e] = p[e] + (pv[e] - p[e]) * P.mk[e];
    unpk8(R.pv, p); unpk8(R.qv, pv);
#pragma unroll
    for (int e = 0; e < 8; ++e) v[e] = p[e] + (pv[e] - p[e]) * P.mv[e];
    unpk8(R.dp, dp); unpk8(R.ip, ip);
    float ss = 0.f;
#pragma unroll
    for (int e = 0; e < 8; ++e) {
        const float sg = sigm(P.w0[e] + dp[e]);
        w[e] = __builtin_amdgcn_exp2f(-0.6065306597126334f * LOG2E * sg);
        ic[e] = sigm(P.a0[e] + ip[e]);
        kv[e] = k[e] * P.kk[e]; ss += kv[e] * kv[e];
        km[e] = k[e] * (1.0f + (ic[e] - 1.0f) * P.ka[e]);
    }
    ss = red8(ss);
    const float inv = 1.0f / fmaxf(sqrtf(ss), 1e-12f);
#pragma unroll
    for (int e = 0; e < 8; ++e) { const float kn = kv[e] * inv; a[e] = -kn; b[e] = kn * ic[e]; }
    const int o = s * SLOTB + 32 * cg;
    *(LAS f32x4*)(lds + OP_R + o) = (f32x4){r[0], r[1], r[2], r[3]}; *(LAS f32x4*)(lds + OP_R + o + 16) = (f32x4){r[4], r[5], r[6], r[7]};
    *(LAS f32x4*)(lds + OP_W + o) = (f32x4){w[0], w[1], w[2], w[3]}; *(LAS f32x4*)(lds + OP_W + o + 16) = (f32x4){w[4], w[5], w[6], w[7]};
    *(LAS f32x4*)(lds + OP_K + o) = (f32x4){km[0], km[1], km[2], km[3]}; *(LAS f32x4*)(lds + OP_K + o + 16) = (f32x4){km[4], km[5], km[6], km[7]};
    *(LAS f32x4*)(lds + OP_A + o) = (f32x4){a[0], a[1], a[2], a[3]}; *(LAS f32x4*)(lds + OP_A + o + 16) = (f32x4){a[4], a[5], a[6], a[7]};
    *(LAS f32x4*)(lds + OP_B + o) = (f32x4){b[0], b[1], b[2], b[3]}; *(LAS f32x4*)(lds + OP_B + o + 16) = (f32x4){b[4], b[5], b[6], b[7]};
    if ((cg >> 1) == q) { const int ov = (s * 16 + (cg & 1) * 8) * 4;
        *(LAS f32x4*)(lds + SC_V + ov) = (f32x4){v[0], v[1], v[2], v[3]}; *(LAS f32x4*)(lds + SC_V + ov + 16) = (f32x4){v[4], v[5], v[6], v[7]}; }
}
struct Ops { f32x4 a, w, b, k, r; float vv; };
__device__ __forceinline__ Ops ops_load(const LAS unsigned char* pb, const LAS unsigned char* pv) {
    Ops x;
    x.a = *(const LAS f32x4*)(pb + OP_A); x.w = *(const LAS f32x4*)(pb + OP_W); x.b = *(const LAS f32x4*)(pb + OP_B);
    x.k = *(const LAS f32x4*)(pb + OP_K); x.r = *(const LAS f32x4*)(pb + OP_R);
    x.vv = *(const LAS float*)pv;
    return x;
}
__device__ __forceinline__ float fmul_s(float a, float b) { float d; asm("v_mul_f32 %0, %1, %2" : "=v"(d) : "v"(a), "v"(b)); return d; }
__device__ __forceinline__ float fadd_s(float a, float b) { float d; asm("v_add_f32 %0, %1, %2" : "=v"(d) : "v"(a), "v"(b)); return d; }
__device__ __forceinline__ float ffma_s(float a, float b, float c) { float d; asm("v_fma_f32 %0, %1, %2, %3" : "=v"(d) : "v"(a), "v"(b), "v"(c)); return d; }
__device__ __forceinline__ float ops_step(const Ops& x, f32x4& S) {
    float p0 = fmul_s(S.x, x.a.x), p1 = fmul_s(S.z, x.a.z);
    p0 = ffma_s(S.y, x.a.y, p0); p1 = ffma_s(S.w, x.a.w, p1);
    float sa = fadd_s(p0, p1);
    float t0 = fmul_s(x.vv, x.k.x), t1 = fmul_s(x.vv, x.k.y), t2 = fmul_s(x.vv, x.k.z), t3 = fmul_s(x.vv, x.k.w);
    sa = red16(sa);
    t0 = ffma_s(S.x, x.w.x, t0); t1 = ffma_s(S.y, x.w.y, t1); t2 = ffma_s(S.z, x.w.z, t2); t3 = ffma_s(S.w, x.w.w, t3);
    S.x = ffma_s(sa, x.b.x, t0); S.y = ffma_s(sa, x.b.y, t1); S.z = ffma_s(sa, x.b.z, t2); S.w = ffma_s(sa, x.b.w, t3);
    float q0 = fmul_s(S.x, x.r.x), q1 = fmul_s(S.z, x.r.z);
    q0 = ffma_s(S.y, x.r.y, q0); q1 = ffma_s(S.w, x.r.w, q1);
    return red16(fadd_s(q0, q1));
}
__device__ __forceinline__ void p9_scan(KP A, LAS unsigned char* lds, int tid, int wave, int lane) {
    const int s_of = tid >> 3, cg = tid & 7;
    const int w4 = wave & 3, row16 = 4 * w4 + (lane >> 4), kq = lane & 15;
    for (int item = blockIdx.x; item < 256; item += gridDim.x) {
        const int seq = item >> 5, h = (item >> 2) & 7, q = item & 3;
        const int m_base = seq * TSEQ;
        if (wave < 4) {
            f32x4 S = (f32x4){0.f, 0.f, 0.f, 0.f};
#ifdef PROBE_SCAN2
            f32x4 S2 = (f32x4){1.f, 0.f, 0.f, 0.f};
#endif
            LBAR();
            for (int c = 0; c < 64; ++c) {
                const int s0 = (c & 1) * 32;
                const LAS unsigned char* pb = lds + s0 * SLOTB + 16 * kq;
                const LAS unsigned char* pv = lds + SC_V + (s0 * 16 + row16) * 4;
                LAS unsigned char* py = lds + SC_Y + (s0 * 16 + row16) * 4;
                Ops cur = ops_load(pb, pv), nx1 = ops_load(pb + SLOTB, pv + 64);
                for (int s = 0; s < 32; s += 4) {
#pragma unroll
                    for (int u = 0; u < 4; ++u) {
                        const Ops nx2 = ops_load(pb + (s + u + 2) * SLOTB, pv + (s + u + 2) * 64);
                        const float y = ops_step(cur, S);
#ifdef PROBE_SCAN2
                        { const float y2 = ops_step(cur, S2); asm volatile("" :: "v"(y2)); }
#endif
                        if (kq == 0) *(LAS float*)(py + (s + u) * 64) = y;
                        cur = nx1; nx1 = nx2;
                    }
                }
                LBAR();
            }
            *(f32x4*)(A->out + O_WKVP + ((size_t)(seq * 8 + h) * 64 + q * 16 + row16) * 64 + 4 * kq) = S;
        } else {
            const int pt = tid - 256, sl = pt >> 3, pcg = pt & 7, gc = h * 64 + 8 * pcg;
            Par P;
            ld8f(A->in[14] + gc, P.mr); ld8f(A->in[14] + 512 + gc, P.mk); ld8f(A->in[14] + 1024 + gc, P.mv);
            ld8f(A->in[15] + gc, P.w0); ld8f(A->in[17] + gc, P.a0); ld8f(A->in[20] + gc, P.kk); ld8f(A->in[21] + gc, P.ka);
            bf16_t* YZ = (bf16_t*)(A->ws + WS_H);
            Raw R;
            raw_load(A, m_base + sl, sl == 0, gc, R);
            prep_store_raw(lds, R, P, sl, pcg, q);
            raw_load(A, m_base + 32 + sl, false, gc, R);
            LBAR();
            for (int c = 0; c < 64; ++c) {
                Raw Rn = R;
                if (c + 2 < 64) raw_load(A, m_base + (c + 2) * 32 + sl, false, gc, Rn);
                if (c >= 1) {
                    const int sb = ((c - 1) & 1) * 32 + sl;
                    const float y0 = *(const LAS float*)(lds + SC_Y + (sb * 16 + 2 * pcg) * 4), y1 = *(const LAS float*)(lds + SC_Y + (sb * 16 + 2 * pcg + 1) * 4);
                    *(unsigned*)(YZ + (size_t)(m_base + (c - 1) * 32 + sl) * DM + h * 64 + q * 16 + 2 * pcg) = pk2(y0, y1);
                }
                if (c + 1 < 64) prep_store_raw(lds, R, P, ((c + 1) & 1) * 32 + sl, pcg, q);
#ifdef PROBE_PREP2
                asm volatile("" : "+v"(R.pr), "+v"(R.pk), "+v"(R.pv), "+v"(R.qr), "+v"(R.qk), "+v"(R.qv), "+v"(R.dp), "+v"(R.ip));
                if (c + 1 < 64) prep_store_raw(lds, R, P, ((c + 1) & 1) * 32 + sl, pcg, q);
#endif
                R = Rn;
                LBAR();
            }
            { const int sb = 32 + sl;
              const float y0 = *(const LAS float*)(lds + SC_Y + (sb * 16 + 2 * pcg) * 4), y1 = *(const LAS float*)(lds + SC_Y + (sb * 16 + 2 * pcg + 1) * 4);
              *(unsigned*)(YZ + (size_t)(m_base + 63 * 32 + sl) * DM + h * 64 + q * 16 + 2 * pcg) = pk2(y0, y1); }
        }
        __syncthreads();
    }
    for (int grp = blockIdx.x; grp < 256; grp += gridDim.x) {
        const Slot x = slot_sample(grp, s_of);
        scan_prep_store(A, lds, x, s_of, cg);
        const int half = wave >> 2;
        f32x4 S[8];
#pragma unroll
        for (int j = 0; j < 8; ++j) { const int i = grp * 16 + half * 8 + j, seq = i >> 5, h = (i >> 2) & 7, q = i & 3;
            S[j] = *(const f32x4*)(A->in[4] + ((size_t)(seq * 8 + h) * 64 + q * 16 + row16) * 64 + 4 * kq); }
        __syncthreads();
#pragma unroll
        for (int j = 0; j < 8; ++j) {
#pragma unroll
            for (int t = 0; t < 4; ++t) scan_step(lds, (half * 8 + j) * 4 + t, row16, kq, S[j]);
        }
#pragma unroll
        for (int j = 0; j < 8; ++j) { const int i = grp * 16 + half * 8 + j, seq = i >> 5, h = (i >> 2) & 7, q = i & 3;
            *(f32x4*)(A->out + O_WKVS + ((size_t)(seq * 8 + h) * 64 + q * 16 + row16) * 64 + 4 * kq) = S[j]; }
        __syncthreads();
        scan_store_y(A, lds, x, s_of, cg);
        __syncthreads();
    }
}

__device__ __forceinline__ void p10_finalize(KP A, int wave, int lane) {
    const int gw = blockIdx.x * 8 + wave, NGW = gridDim.x * 8;
    bf16_t* YZ = (bf16_t*)(A->ws + WS_H); const bf16_t* LR = (const bf16_t*)(A->ws + WS_D);
    float lg[8], lb[8]; ld8f(A->in[23] + 8 * lane, lg); ld8f(A->in[24] + 8 * lane, lb);
    for (int m = gw; m < MT; m += NGW) {
        Slot x; x.m = m; x.h = lane >> 3; x.q = 0;
        if (m < NPT) { x.seq = m >> 11; x.first = ((m & 2047) == 0); x.sample = false; } else { const int ms = m - NPT; x.seq = ms >> 2; x.first = ((ms & 3) == 0); x.sample = true; }
        float r[8], w[8], km[8], v[8], a[8], b[8];
        float bon = rwkv_prep8(A, x, lane & 7, r, w, km, v, a, b);
        bon = red8(bon);
        float y[8], gt[8]; ld8bf(YZ + (size_t)m * DM + 8 * lane, y); ld8bf(LR + (size_t)m * NLR + 1024 + 8 * lane, gt);
        float s = 0.f;
#pragma unroll
        for (int e = 0; e < 8; ++e) s += y[e];
        const float mean = red8(s) * (1.0f / 64.0f); float qv = 0.f;
#pragma unroll
        for (int e = 0; e < 8; ++e) { y[e] -= mean; qv += y[e] * y[e]; }
        const float rs = rsq(red8(qv) * (1.0f / 64.0f) + GN_EPS);
        float o[8];
#pragma unroll
        for (int e = 0; e < 8; ++e) o[e] = (y[e] * rs * lg[e] + lb[e] + bon * v[e]) * gt[e];
        u32x4 wv; wv.x = pk2(o[0], o[1]); wv.y = pk2(o[2], o[3]); wv.z = pk2(o[4], o[5]); wv.w = pk2(o[6], o[7]);
        *(u32x4*)(YZ + (size_t)m * DM + 8 * lane) = wv;
    }
}

#define XB_TMO      128
#define XB_XCNT(j)  (256  + 64 * (j))
#define XB_XSUB(j)  (1280 + 64 * (j))
#define XB_XGEN(j)  (2304 + 64 * (j))
#define XB_TOP      3328
#define XB_TOPGEN   3392
#define XCD_BAR_WORDS 3456
#define XB_SPIN_CAP (1u << 18)

__device__ __forceinline__ unsigned xb_ld(unsigned* p)              { return __hip_atomic_load(p, __ATOMIC_RELAXED, __HIP_MEMORY_SCOPE_AGENT); }
__device__ __forceinline__ unsigned xb_add(unsigned* p, unsigned v) { return __hip_atomic_fetch_add(p, v, __ATOMIC_RELAXED, __HIP_MEMORY_SCOPE_AGENT); }
__device__ __forceinline__ unsigned xb_xcc_id() { return (unsigned)__builtin_amdgcn_s_getreg((3 << 11) | 20) & 0xFu; }
#define XB_SPIN(cond, bar) do { unsigned _sp = 0; while (cond) { __builtin_amdgcn_s_sleep(1); \
    if ((++_sp & 255u) == 0u) { if (xb_ld(&(bar)[XB_TMO])) break; if (_sp > XB_SPIN_CAP) { atomicAdd(&(bar)[XB_TMO], 1u); break; } } } } while (0)

struct XcdBarrier {
    unsigned* bar; unsigned x;
    volatile LAS unsigned* st;
};

__device__ __forceinline__ XcdBarrier xcd_barrier_post(unsigned* bar, volatile LAS unsigned* st) {
    XcdBarrier b; b.bar = bar; b.x = xb_xcc_id(); b.st = st;
    if (threadIdx.x == 0) (void)xb_add(&bar[XB_XCNT(b.x)], 1u);
    return b;
}
__device__ __forceinline__ void xcd_barrier_complete(unsigned* bar, unsigned x, unsigned& nloc, unsigned& nx) {
    const unsigned G = gridDim.x * gridDim.y * gridDim.z;
    unsigned sum, cnt, mine, sp = 0u;
    for (;;) {
        sum = 0u; cnt = 0u; mine = 0u;
#pragma unroll
        for (unsigned j = 0; j < 16; ++j) { const unsigned c = xb_ld(&bar[XB_XCNT(j)]); sum += c; cnt += (c > 0u) ? 1u : 0u; mine = (j == x) ? c : mine; }
        if (sum == G) break;
        __builtin_amdgcn_s_sleep(1);
        if ((++sp & 255u) == 0u) { if (xb_ld(&bar[XB_TMO])) break; if (sp > XB_SPIN_CAP) { atomicAdd(&bar[XB_TMO], 1u); break; } }
    }
    nloc = mine > 0u ? mine : 1u; nx = cnt > 0u ? cnt : 1u;
}

__device__ __forceinline__ void xcd_barrier(const XcdBarrier& b) {
    asm volatile("s_waitcnt vmcnt(0)" ::: "memory");
    __syncthreads();
    if (threadIdx.x == 0) {
        unsigned* bar = b.bar;
        __builtin_amdgcn_s_waitcnt(0);
        unsigned nloc = b.st[0], nx = b.st[1];
        if (nloc == 0u) { xcd_barrier_complete(bar, b.x, nloc, nx); b.st[0] = nloc; b.st[1] = nx; }
        const unsigned old = xb_add(&bar[XB_XSUB(b.x)], 1u);
        const unsigned gen = old / nloc;
        if (old + 1u == (gen + 1u) * nloc) {
            __builtin_amdgcn_fence(__ATOMIC_RELEASE, "agent");
            asm volatile("s_waitcnt vmcnt(0)" ::: "memory");
            const unsigned og = xb_add(&bar[XB_TOP], 1u);
            const unsigned tg = og / nx;
            if (og + 1u == (tg + 1u) * nx) xb_add(&bar[XB_TOPGEN], 1u);
            else XB_SPIN(xb_ld(&bar[XB_TOPGEN]) == tg, bar);
            __builtin_amdgcn_fence(__ATOMIC_ACQUIRE, "agent");
            xb_add(&bar[XB_XGEN(b.x)], 1u);
            asm volatile("s_waitcnt vmcnt(0)" ::: "memory");
        } else {
            XB_SPIN(xb_ld(&bar[XB_XGEN(b.x)]) == gen, bar);
            __builtin_amdgcn_fence(__ATOMIC_ACQUIRE, "agent");
            asm volatile("s_waitcnt vmcnt(0)" ::: "memory");
        }
    }
    __syncthreads();
}

#ifndef PHMASK
#define PHMASK 0xFFFF
#endif
constexpr int NPH = 16;
__global__ void __launch_bounds__(512) mk_fwd(KArgs A_unused) {
    extern __shared__ __attribute__((aligned(16))) unsigned char lds_raw[];
    LAS unsigned char* lds = (LAS unsigned char*)lds_raw;
    cg::grid_group grid = cg::this_grid();
#ifndef REPMASK
#define REPMASK 0
#endif
#ifndef XSYNC
#define XSYNC 0
#endif
    for (int k = 0; k < XSYNC; ++k) grid.sync();
    if (((KP)__builtin_amdgcn_kernarg_segment_ptr())->ws == nullptr) grid.sync();
    if (threadIdx.x < 2) ((volatile LAS unsigned*)(lds + LDS_CTL_OFF))[threadIdx.x] = 0u;
    __syncthreads();
    XcdBarrier bar = xcd_barrier_post((unsigned*)(((KP)__builtin_amdgcn_kernarg_segment_ptr())->ws + WS_CTL), (volatile LAS unsigned*)(lds + LDS_CTL_OFF));
    for (int phi = 0; phi < NPH + __builtin_popcount(REPMASK); ++phi) {
        int ph = phi;
        if (REPMASK) { int c = 0; ph = 0; for (int q = 0; q < NPH; ++q) { const int n = 1 + ((REPMASK >> q) & 1); if (phi >= c && phi < c + n) ph = q; c += n; } }
        KP kp = (KP)__builtin_amdgcn_kernarg_segment_ptr(); asm volatile("" : "+s"(kp));
        int tid_ = threadIdx.x; asm volatile("" : "+v"(tid_));
        const int tid = tid_, lane = tid & 63, wave = __builtin_amdgcn_readfirstlane(tid >> 6);
        const KP A = kp;
        unsigned char* ws = A->ws;
        switch (ph) {
        case 0: if constexpr ((PHMASK & 0x1) != 0) p0_prologue(A, lds, tid, wave, lane); break;
        case 1: if constexpr ((PHMASK & 0x2) != 0) { pg8::Gemm g{(const bf16_t*)(ws + WS_SC), (const bf16_t*)(ws + WS_WADA), 256, NADA, DM, DM}; pg8::StaticOrder S; S.init(256, NADA, gridDim.x, blockIdx.x);
                  pg8::EpiF32B E{(float*)(ws + WS_ADA), NADA, A->in[8]};
                  pg8::gemm_phase<pg8::EpiF32B, pg8::StaticOrder, true, true>(lds, g, S, E); } break;
        case 2: if constexpr ((PHMASK & 0x4) != 0) row_pass<0>(A, wave, lane, 0, 0.f, 0, 0); break;
        case 3: case 13: if constexpr ((PHMASK & 0x2008) != 0) { pg8::Gemm g{(const bf16_t*)(ws + WS_H), (const bf16_t*)(ws + (ph == 3 ? WS_WUP1 : WS_WUP2)), MT, NUP, DM, DM}; pg8::StaticOrder S; S.init(MT, NUP, gridDim.x, blockIdx.x);
                  pg8::EpiSwiglu E{(bf16_t*)(ws + WS_ACT), DFF};
                  pg8::gemm_phase<pg8::EpiSwiglu, pg8::StaticOrder, true, true>(lds, g, S, E); } break;
        case 4: case 6: case 8: case 11: case 14: if constexpr ((PHMASK & 0x4950) != 0) {
                  pg8::Gemm g; pg8::EpiBf16P E; int nsplit = 0;
                  if (ph == 4)       { g = pg8::Gemm{(const bf16_t*)(ws + WS_ACT), (const bf16_t*)(ws + WS_WDN1), NPT, DM, DFF, DFF}; E = pg8::EpiBf16P{(bf16_t*)(ws + WS_D), DM}; nsplit = 11; }
                  else if (ph == 14) { g = pg8::Gemm{(const bf16_t*)(ws + WS_ACT), (const bf16_t*)(ws + WS_WDN2), NPT, DM, DFF, DFF}; E = pg8::EpiBf16P{(bf16_t*)(ws + WS_D), DM}; nsplit = 11; }
                  else if (ph == 6)  { g = pg8::Gemm{(const bf16_t*)(ws + WS_H), (const bf16_t*)(ws + WS_WIN), MT, DIN, DM, DM}; E = pg8::EpiBf16P{(bf16_t*)(ws + WS_ACT), DIN}; }
                  else if (ph == 8)  { g = pg8::Gemm{(const bf16_t*)(ws + WS_L), (const bf16_t*)(ws + WS_WLR), MT, NLR, KLR, KLR}; E = pg8::EpiBf16P{(bf16_t*)(ws + WS_D), NLR}; }
                  else               { g = pg8::Gemm{(const bf16_t*)(ws + WS_H), (const bf16_t*)(ws + WS_WOUT), NPT, DM, DM, DM}; E = pg8::EpiBf16P{(bf16_t*)(ws + WS_D), DM}; nsplit = 4; }
                  pg8::StaticOrder S; S.init(g.M, g.N, gridDim.x, blockIdx.x);
                  pg8::gemm_phase<pg8::EpiBf16P, pg8::StaticOrder, true, true>(lds, g, S, E);
                  if (nsplit) {
                      const int KS = g.ld / nsplit;
                      pg8::Gemm g2{g.A, g.Bt, MT, DM, KS, g.ld};
                      pg8::SplitKOrder S2{4, nsplit, KS, (int)gridDim.x, (int)blockIdx.x, NPT / 256};
                      pg8::EpiPartial E2{(float*)(ws + WS_PART), KS, NPT / 256};
                      pg8::gemm_phase<pg8::EpiPartial, pg8::SplitKOrder, true, true>(lds, g2, S2, E2);
                  } } break;
        case 5: if constexpr ((PHMASK & 0x20) != 0) row_pass<1>(A, wave, lane, 0, 0.5f, 1, 11); break;
        case 7: if constexpr ((PHMASK & 0x80) != 0) { p7_lowrank_inputs(A, wave, lane); p7_conv(A, lds, tid, wave, lane); } break;
        case 9: if constexpr ((PHMASK & 0x200) != 0) p9_scan(A, lds, tid, wave, lane); break;
        case 10: if constexpr ((PHMASK & 0x400) != 0) p10_finalize(A, wave, lane); break;
        case 12: if constexpr ((PHMASK & 0x1000) != 0) row_pass<1>(A, wave, lane, 1, 1.0f, 2, 4); break;
        case 15: if constexpr ((PHMASK & 0x8000) != 0) row_pass<2>(A, wave, lane, 2, 0.5f, 0, 11); break;
        }
        if (phi + 1 < NPH + __builtin_popcount(REPMASK)) xcd_barrier(bar);
#ifdef XBAR
        if (ph == 4) { for (int k = 0; k < XBAR; ++k) xcd_barrier(bar); }
#endif
    }
}

extern "C" void kernel_launch(void* const* d_in, const int* in_sizes, int n_in, void* d_out, int out_size, void* d_ws, size_t ws_size, hipStream_t stream) {
    static int grid = 0;
    if (grid == 0) {
        if (n_in != 32 || out_size != (int)O_END || ws_size < WS_CTL + CTL_BYTES) { fprintf(stderr, "kernel_launch: unexpected shapes: n_in %d out %d ws %zu (need %zu)\n", n_in, out_size, ws_size, (size_t)WS_END); grid = -1; return; }
        int dev = 0, cus = 0, per_cu = 0;
        hipGetDevice(&dev);
        hipDeviceGetAttribute(&cus, hipDeviceAttributeMultiprocessorCount, dev);
        if (hipFuncSetAttribute((const void*)mk_fwd, hipFuncAttributeMaxDynamicSharedMemorySize, LDS_BYTES) != hipSuccess) { fprintf(stderr, "kernel_launch: hipFuncSetAttribute failed\n"); grid = -1; return; }
        if (hipOccupancyMaxActiveBlocksPerMultiprocessor(&per_cu, (const void*)mk_fwd, 512, LDS_BYTES) != hipSuccess || per_cu < 1) { fprintf(stderr, "kernel_launch: occupancy query failed (%d)\n", per_cu); (void)hipGetLastError(); per_cu = 1; }
        grid = cus * per_cu;
        fprintf(stderr, "kernel_launch: cus %d per_cu %d grid %d\n", cus, per_cu, grid);
    }
    if (grid < 0) return;
    KArgs a{};
    for (int i = 0; i < 32; ++i) a.in[i] = (const float*)d_in[i];
    a.out = (float*)d_out; a.ws = (unsigned char*)d_ws;
    if (hipMemsetAsync((char*)d_ws + WS_CTL, 0, CTL_BYTES, stream) != hipSuccess) { fprintf(stderr, "kernel_launch: memset failed\n"); return; }
    void* args[] = {&a};
    hipError_t e = hipLaunchCooperativeKernel((const void*)mk_fwd, dim3(grid), dim3(512), args, LDS_BYTES, stream);
    if (e != hipSuccess) fprintf(stderr, "kernel_launch: cooperative launch failed: %s (grid %d)\n", hipGetErrorString(e), grid);
}
```
